# Optimizing an MI355X kernel written in HIP

```python
import math
import jax, jax.numpy as jnp
from jax import lax
import numpy as np

D_MODEL = 1024
BATCH = 8
SEQ = 2048
DEPTH = 2

HEAD_DIM = 64
A_HEADS = 8
A_KV_HEADS = 2
WINDOW = 128
A_BLOCK = 128
B_HEADS = 4
B_BLOCK = 128
C_HEADS = 8
GRID_W = 64
NA_ROWS = 8
NA_COLS = 16
NA_COL_BLOCK = 16
NA_KEY_COLS = NA_COL_BLOCK + NA_COLS
MIX_W = 512
N_BRANCH = 3
N_EXPERTS = 32
TOP_K = 4
D_EXPERT = 1024
MOE_BLOCK = 128
SWIGLU_LIMIT = 7.0
SWIGLU_ALPHA = 1.702
LN_EPS = 1e-5
NEG_INF = -1e30
DEEPNORM_ALPHA = (2 * DEPTH) ** 0.25
DEEPNORM_BETA = (8 * DEPTH) ** -0.25

A_Q_W = A_HEADS * HEAD_DIM
A_KV_W = A_KV_HEADS * HEAD_DIM
B_QK_W = B_HEADS * 2 * HEAD_DIM
B_V_W = B_HEADS * 2 * HEAD_DIM
C_W = C_HEADS * HEAD_DIM
GATE_W = N_BRANCH * D_MODEL
IN_SPLITS = (A_Q_W, A_KV_W, A_KV_W, B_QK_W, B_QK_W, B_V_W, C_W, C_W, C_W, GATE_W)
IN_W = sum(IN_SPLITS)

kernel_name = "hybrid_gated_swa_diff_na_moe_encoder"


def layer_norm(x, g, b):
    xf = x.astype(jnp.float32)
    mu = jnp.mean(xf, axis=-1, keepdims=True)
    var = jnp.mean(jnp.square(xf - mu), axis=-1, keepdims=True)
    y = (xf - mu) * lax.rsqrt(var + LN_EPS) * g.astype(jnp.float32) + b.astype(jnp.float32)
    return y.astype(x.dtype)


def alibi_slopes():
    n = A_HEADS + B_HEADS
    return jnp.asarray(2.0 ** (-8.0 * np.arange(1, n + 1) / n), dtype=jnp.float32)


def windowed_gqa_sink(q, k, v, sink, slopes):
    bsz, seq = q.shape[0], q.shape[1]
    nb = seq // A_BLOCK
    grp = A_HEADS // A_KV_HEADS

    def band(t):
        tp = jnp.pad(t, ((0, 0), (A_BLOCK, A_BLOCK), (0, 0), (0, 0)))
        tp = tp.reshape(bsz, nb + 2, A_BLOCK, A_KV_HEADS, HEAD_DIM)
        return jnp.concatenate([tp[:, :-2], tp[:, 1:-1], tp[:, 2:]], axis=2)

    kb, vb = band(k), band(v)
    qb = q.reshape(bsz, nb, A_BLOCK, A_KV_HEADS, grp, HEAD_DIM)
    s = jnp.einsum('bnqgrd,bnkgd->bngrqk', qb, kb).astype(jnp.float32) * (HEAD_DIM ** -0.5)
    qi = np.arange(A_BLOCK)[:, None]
    ki = np.arange(3 * A_BLOCK)[None, :]
    rel = ki - A_BLOCK - qi
    kpos = (np.arange(nb)[:, None, None] - 1) * A_BLOCK + ki[None]
    valid = (np.abs(rel) <= WINDOW)[None] & (kpos >= 0) & (kpos < seq)
    dist = jnp.asarray(np.abs(rel), dtype=jnp.float32)
    bias = -slopes.reshape(A_KV_HEADS, grp, 1, 1) * dist
    s = jnp.where(valid[None, :, None, None], s + bias, NEG_INF)
    sink_logit = jnp.broadcast_to(sink.astype(jnp.float32).reshape(1, 1, A_KV_HEADS, grp, 1, 1),
                                  s.shape[:-1] + (1,))
    p = jax.nn.softmax(jnp.concatenate([s, sink_logit], axis=-1), axis=-1)[..., :-1]
    o = jnp.einsum('bngrqk,bnkgd->bnqgrd', p.astype(v.dtype), vb)
    return o.reshape(bsz, seq, A_Q_W)


def diff_attention(q, k, v, lam, lam_init, gain, slopes):
    bsz, seq = q.shape[0], q.shape[1]
    nb = seq // B_BLOCK
    kpos = jnp.arange(seq, dtype=jnp.float32)
    qblocks = q.reshape(bsz, nb, B_BLOCK, B_HEADS, 2, HEAD_DIM).swapaxes(0, 1)

    def block(args):
        qb, i = args
        qpos = i.astype(jnp.float32) * B_BLOCK + jnp.arange(B_BLOCK, dtype=jnp.float32)
        s = jnp.einsum('bqhmd,bkhmd->bhmqk', qb, k).astype(jnp.float32) * (HEAD_DIM ** -0.5)
        s = s - slopes[:, None, None, None] * jnp.abs(qpos[:, None] - kpos[None, :])
        p = jax.nn.softmax(s, axis=-1)
        a = p[:, :, 0] - lam * p[:, :, 1]
        return jnp.einsum('bhqk,bkhe->bqhe', a.astype(v.dtype), v)

    o = lax.map(block, (qblocks, jnp.arange(nb)))
    o = o.swapaxes(0, 1).reshape(bsz, seq, B_HEADS, 2 * HEAD_DIM).astype(jnp.float32)
    o = o * lax.rsqrt(jnp.mean(jnp.square(o), axis=-1, keepdims=True) + LN_EPS)
    o = o * gain.astype(jnp.float32) * (1.0 - lam_init)
    return o.astype(v.dtype).reshape(bsz, seq, B_V_W)


def neighbourhood_attention(q, k, v, rpb):
    bsz, seq = q.shape[0], q.shape[1]
    rows = seq // GRID_W
    kr = min(NA_ROWS, rows)
    ncb = GRID_W // NA_COL_BLOCK
    r = np.arange(rows)
    rs = np.clip(r - kr // 2, 0, rows - kr)
    rows_idx = rs[:, None] + np.arange(kr)[None, :]
    cbs = np.clip(np.arange(ncb) * NA_COL_BLOCK - NA_COLS // 2, 0, GRID_W - NA_KEY_COLS)
    cols_idx = cbs[:, None] + np.arange(NA_KEY_COLS)[None, :]
    qc = np.arange(ncb)[:, None] * NA_COL_BLOCK + np.arange(NA_COL_BLOCK)[None, :]
    cs = np.clip(qc - NA_COLS // 2, 0, GRID_W - NA_COLS)
    kc = cols_idx[:, None, :]
    valid = (kc >= cs[:, :, None]) & (kc < cs[:, :, None] + NA_COLS)
    dri = rows_idx - r[:, None] + NA_ROWS - 1
    dci = np.clip(kc - qc[:, :, None] + NA_COLS - 1, 0, 2 * NA_COLS - 2)

    qg = q.reshape(bsz, rows, ncb, NA_COL_BLOCK, C_HEADS, HEAD_DIM)
    kg = k.reshape(bsz, rows, GRID_W, C_HEADS, HEAD_DIM)
    vg = v.reshape(bsz, rows, GRID_W, C_HEADS, HEAD_DIM)
    ridx = rows_idx[:, None, :, None]
    cidx = cols_idx[None, :, None, :]
    kn = kg[:, ridx, cidx]
    vn = vg[:, ridx, cidx]
    s = jnp.einsum('brjqhd,brjuvhd->brjhquv', qg, kn).astype(jnp.float32) * (HEAD_DIM ** -0.5)
    bias = rpb.astype(jnp.float32)[:, dri[:, :, None, None, None], dci[None, None]]
    bias = bias.transpose(1, 3, 0, 4, 2, 5)
    s = jnp.where(valid[None, None, :, None, :, None, :], s + bias[None], NEG_INF)
    shp = s.shape
    p = jax.nn.softmax(s.reshape(shp[:-2] + (kr * NA_KEY_COLS,)), axis=-1).reshape(shp)
    o = jnp.einsum('brjhquv,brjuvhd->brjqhd', p.astype(v.dtype), vn)
    return o.reshape(bsz, seq, C_W)


def hybrid_mixer(h, layer, w_in, a_sink, lambda_q1, lambda_k1, lambda_q2, lambda_k2,
                 diff_norm_g, na_rpb, w_branch, w_out):
    bsz, seq, _ = h.shape
    proj = h @ w_in
    offs = np.cumsum(IN_SPLITS)[:-1].tolist()
    aq, ak, av, bq, bk, bv, cq, ck, cv, g = jnp.split(proj, offs, axis=-1)
    slopes = alibi_slopes()

    oa = windowed_gqa_sink(aq.reshape(bsz, seq, A_HEADS, HEAD_DIM),
                           ak.reshape(bsz, seq, A_KV_HEADS, HEAD_DIM),
                           av.reshape(bsz, seq, A_KV_HEADS, HEAD_DIM),
                           a_sink, slopes[:A_HEADS])

    lam_init = 0.8 - 0.6 * math.exp(-0.3 * layer)
    f32 = jnp.float32
    lam = (jnp.exp(jnp.sum(lambda_q1.astype(f32) * lambda_k1.astype(f32)))
           - jnp.exp(jnp.sum(lambda_q2.astype(f32) * lambda_k2.astype(f32))) + lam_init)
    ob = diff_attention(bq.reshape(bsz, seq, B_HEADS, 2, HEAD_DIM),
                        bk.reshape(bsz, seq, B_HEADS, 2, HEAD_DIM),
                        bv.reshape(bsz, seq, B_HEADS, 2 * HEAD_DIM),
                        lam, lam_init, diff_norm_g, slopes[A_HEADS:])

    oc = neighbourhood_attention(cq.reshape(bsz, seq, C_HEADS, HEAD_DIM),
                                 ck.reshape(bsz, seq, C_HEADS, HEAD_DIM),
                                 cv.reshape(bsz, seq, C_HEADS, HEAD_DIM), na_rpb)

    branches = jnp.stack([oa, ob, oc], axis=2)
    br = jnp.einsum('bsmc,mcd->bsmd', branches, w_branch)
    gates = jax.nn.sigmoid(g.reshape(bsz, seq, N_BRANCH, D_MODEL))
    merged = jnp.sum(gates * br, axis=2)
    return merged @ w_out


def moe_ffn(x, w_router, b_router, w_up, b_up, w_down, b_down):
    bsz, seq, d = x.shape
    n = bsz * seq
    xf = x.reshape(n, d)
    logits = (xf @ w_router + b_router).astype(jnp.float32)
    top_vals, top_idx = lax.top_k(logits, TOP_K)
    gate_w = jax.nn.softmax(top_vals, axis=-1)
    n_assign = n * TOP_K
    flat_e = top_idx.reshape(-1).astype(jnp.int32)
    flat_tok = (jnp.arange(n_assign, dtype=jnp.int32) // TOP_K)
    flat_w = gate_w.reshape(-1)
    order = jnp.argsort(flat_e)
    sorted_e = flat_e[order]
    counts = jnp.bincount(flat_e, length=N_EXPERTS)
    padded = (counts + MOE_BLOCK - 1) // MOE_BLOCK * MOE_BLOCK
    start = jnp.cumsum(counts) - counts
    pend = jnp.cumsum(padded)
    pstart = pend - padded
    dest = pstart[sorted_e] + (jnp.arange(n_assign, dtype=jnp.int32) - start[sorted_e])
    n_pad = n_assign + N_EXPERTS * MOE_BLOCK
    n_blk = n_pad // MOE_BLOCK
    tok_pad = jnp.full((n_pad,), n, dtype=jnp.int32).at[dest].set(flat_tok[order])
    w_pad = jnp.zeros((n_pad,), jnp.float32).at[dest].set(flat_w[order])
    blk_e = jnp.minimum(jnp.searchsorted(pend, jnp.arange(n_blk) * MOE_BLOCK, side='right'),
                        N_EXPERTS - 1).astype(jnp.int32)
    x_pad = jnp.concatenate([xf, jnp.zeros((1, d), xf.dtype)], axis=0)
    xs = x_pad[tok_pad].reshape(n_blk, MOE_BLOCK, d)

    def expert_block(args):
        xb, e = args
        hh = xb @ w_up[e] + b_up[e]
        hg, hl = hh[:, :D_EXPERT], hh[:, D_EXPERT:]
        hg = jnp.minimum(hg, SWIGLU_LIMIT)
        hl = jnp.clip(hl, -SWIGLU_LIMIT, SWIGLU_LIMIT)
        act = hg * jax.nn.sigmoid(SWIGLU_ALPHA * hg) * (hl + 1.0)
        return act @ w_down[e] + b_down[e]

    ys = lax.map(expert_block, (xs, blk_e)).reshape(n_pad, d)
    out = jnp.zeros((n + 1, d), ys.dtype).at[tok_pad].add(ys * w_pad[:, None].astype(ys.dtype))
    return out[:n].reshape(bsz, seq, d)


def setup_inputs(seed: int = 0) -> dict:
    key = jax.random.key(seed)
    ks = jax.random.split(key, 20)
    L, D, E, F = DEPTH, D_MODEL, N_EXPERTS, D_EXPERT
    nrm = jax.random.normal
    val_scale = [1.0, 1.0, DEEPNORM_BETA, 1.0, 1.0, DEEPNORM_BETA, 1.0, 1.0, DEEPNORM_BETA, 1.0]
    col_scale = jnp.asarray(np.concatenate([np.full(w, s, np.float32)
                                            for w, s in zip(IN_SPLITS, val_scale)]))
    return {
        "x": nrm(ks[0], (BATCH, SEQ, D), jnp.float32),
        "w_in": nrm(ks[1], (L, D, IN_W), jnp.float32) * (D ** -0.5) * col_scale,
        "a_sink": nrm(ks[2], (L, A_HEADS), jnp.float32) * 0.5,
        "lambda_q1": nrm(ks[3], (L, HEAD_DIM), jnp.float32) * 0.1,
        "lambda_k1": nrm(ks[4], (L, HEAD_DIM), jnp.float32) * 0.1,
        "lambda_q2": nrm(ks[5], (L, HEAD_DIM), jnp.float32) * 0.1,
        "lambda_k2": nrm(ks[6], (L, HEAD_DIM), jnp.float32) * 0.1,
        "diff_norm_g": 1.0 + 0.02 * nrm(ks[7], (L, 2 * HEAD_DIM), jnp.float32),
        "na_rpb": 0.05 * nrm(ks[8], (L, C_HEADS, 2 * NA_ROWS - 1, 2 * NA_COLS - 1), jnp.float32),
        "w_branch": nrm(ks[9], (L, N_BRANCH, MIX_W, D), jnp.float32) * (MIX_W ** -0.5),
        "w_out": nrm(ks[10], (L, D, D), jnp.float32) * (D ** -0.5) * DEEPNORM_BETA,
        "ln1_g": 1.0 + 0.02 * nrm(ks[11], (L, D), jnp.float32),
        "ln1_b": 0.02 * nrm(ks[12], (L, D), jnp.float32),
        "w_router": nrm(ks[13], (L, D, E), jnp.float32) * (D ** -0.5),
        "b_router": 0.01 * nrm(ks[14], (L, E), jnp.float32),
        "w_up": nrm(ks[15], (L, E, D, 2 * F), jnp.float32) * (D ** -0.5),
        "b_up": 0.01 * nrm(ks[16], (L, E, 2 * F), jnp.float32),
        "w_down": nrm(ks[17], (L, E, F, D), jnp.float32) * (F ** -0.5) * DEEPNORM_BETA,
        "b_down": 0.01 * nrm(ks[18], (L, E, D), jnp.float32),
        "ln2_g": 1.0 + 0.02 * nrm(ks[19], (L, D), jnp.float32),
        "ln2_b": 0.02 * nrm(jax.random.fold_in(ks[19], 1), (L, D), jnp.float32),
    }


def reference(x, w_in, a_sink, lambda_q1, lambda_k1, lambda_q2, lambda_k2, diff_norm_g, na_rpb,
              w_branch, w_out, ln1_g, ln1_b, w_router, b_router, w_up, b_up, w_down, b_down,
              ln2_g, ln2_b):
    for l in range(DEPTH):
        mix = hybrid_mixer(x, l, w_in[l], a_sink[l], lambda_q1[l], lambda_k1[l], lambda_q2[l],
                           lambda_k2[l], diff_norm_g[l], na_rpb[l], w_branch[l], w_out[l])
        x = layer_norm(DEEPNORM_ALPHA * x + mix, ln1_g[l], ln1_b[l])
        ffn = moe_ffn(x, w_router[l], b_router[l], w_up[l], b_up[l], w_down[l], b_down[l])
        x = layer_norm(DEEPNORM_ALPHA * x + ffn, ln2_g[l], ln2_b[l])
    return x
```

```cpp
#include <hip/hip_runtime.h>
#include <stdint.h>
#include <stdio.h>

#define DI __device__ __forceinline__
typedef unsigned short bf16_t;
typedef unsigned u32x4_t __attribute__((ext_vector_type(4)));

constexpr int NTOK = 16384, DM = 1024, SEQ = 2048, NBATCH = 8;
constexpr int IN_W = 6912;
constexpr int NE = 32, TOPK = 4, FE = 1024;
constexpr int MAXPANELS = 288;
constexpr int NPADROWS = MAXPANELS * 256;
constexpr float LOG2E = 1.4426950408889634f;
constexpr float C2 = 0.125f * 1.4426950408889634f;
constexpr float DN_ALPHA = 1.4142135623730951f;
constexpr float LN_EPS = 1e-5f;
constexpr float SWI_LIMIT = 7.0f, SWI_ALPHA = 1.702f;
constexpr int NRB = 256;

constexpr size_t MiB = 1u << 20;
constexpr size_t WS_CTL = 0;
constexpr size_t WS_TOPI = 1 * MiB;
constexpr size_t WS_TOPW = WS_TOPI + 256 * 1024;
constexpr size_t WS_TSLOT = WS_TOPW + 256 * 1024;
constexpr size_t WS_RTOK = WS_TSLOT + 256 * 1024;
constexpr size_t WS_RW = WS_RTOK + 512 * 1024;
constexpr size_t WS_HIST = WS_RW + 512 * 1024;
constexpr size_t WS_PANE = WS_HIST + 64 * 1024;
constexpr size_t WS_LOGIT = 4 * MiB;
constexpr size_t WS_W = 8 * MiB;
constexpr size_t WL_IN = 0, WL_OUT = 14 * MiB, WL_BR = 16 * MiB, WL_UP = 19 * MiB, WL_DN = 147 * MiB, WL_BYTES = 211 * MiB;
constexpr size_t WS_ACT = WS_W + 2 * WL_BYTES;
constexpr size_t WS_XB = WS_ACT;
constexpr size_t WS_XF = WS_XB + 32 * MiB;
constexpr size_t WS_QA = WS_XF + 64 * MiB;
constexpr size_t WS_KA = WS_QA + 16 * MiB;
constexpr size_t WS_QB = WS_KA + 4 * MiB;
constexpr size_t WS_KB = WS_QB + 16 * MiB;
constexpr size_t WS_QC = WS_KB + 16 * MiB;
constexpr size_t WS_KC = WS_QC + 16 * MiB;
constexpr size_t WS_G = WS_KC + 16 * MiB;
constexpr size_t WS_VT = WS_G + 96 * MiB;
constexpr size_t WS_BR = WS_VT + 40 * MiB;
constexpr size_t WS_MF = WS_BR + 48 * MiB;
constexpr size_t WS_MB = WS_MF + 64 * MiB;
constexpr size_t WS_Y = WS_MB + 32 * MiB;
constexpr size_t WS_X1F = WS_Y + 64 * MiB;
constexpr size_t WS_X1B = WS_X1F + 64 * MiB;
constexpr size_t WS_XS = WS_X1B + 32 * MiB;
constexpr size_t WS_ACTB = WS_XS + 144 * MiB;
constexpr size_t WS_YS = WS_ACTB + 144 * MiB;
constexpr size_t WS_END = WS_YS + 144 * MiB;
static_assert(WS_END <= 2048 * MiB, "workspace map");

DI float bf2f(bf16_t v) { return __uint_as_float(((unsigned)v) << 16); }
DI bf16_t f2bf(float f) { unsigned u = __float_as_uint(f); return (bf16_t)((u + 0x7fffu + ((u >> 16) & 1u)) >> 16); }
DI float wave_sum(float v) {
#pragma unroll
    for (int o = 1; o < 64; o <<= 1) v += __shfl_xor(v, o);
    return v;
}
DI float wave_max(float v) {
#pragma unroll
    for (int o = 1; o < 64; o <<= 1) v = fmaxf(v, __shfl_xor(v, o));
    return v;
}
DI float sigmoidf_(float x) { return 1.f / (1.f + __expf(-x)); }
DI float dot64_bf(const float (&q)[64], const bf16_t* kp) {
    float acc = 0.f;
#pragma unroll
    for (int c = 0; c < 8; ++c) {
        const u32x4_t v = *(const u32x4_t*)(kp + 8 * c);
#pragma unroll
        for (int i = 0; i < 4; ++i) {
            acc += q[8 * c + 2 * i] * __uint_as_float(v[i] << 16);
            acc += q[8 * c + 2 * i + 1] * __uint_as_float(v[i] & 0xffff0000u);
        }
    }
    return acc;
}
DI void load_q64(float (&q)[64], const bf16_t* qp) {
#pragma unroll
    for (int c = 0; c < 8; ++c) {
        const u32x4_t v = *(const u32x4_t*)(qp + 8 * c);
#pragma unroll
        for (int i = 0; i < 4; ++i) { q[8 * c + 2 * i] = __uint_as_float(v[i] << 16); q[8 * c + 2 * i + 1] = __uint_as_float(v[i] & 0xffff0000u); }
    }
}

struct AF32 { const float* p; int ld; int pad; DI float operator()(int m, int k) const { return p[(size_t)m * ld + k]; } };
struct ABF { const bf16_t* p; int ld; int pad; DI float operator()(int m, int k) const { return bf2f(p[(size_t)m * ld + k]); } };
struct AGather { const float* x; const int* row_tok; DI float operator()(int m, int k) const { const int t = row_tok[m]; return (t < 0 || t >= NTOK) ? 0.f : x[(size_t)t * DM + k]; } };
struct BKN { const float* p; int ld; int off2; DI float operator()(int a, int, int k, int n) const { return p[(size_t)k * ld + n + a * off2]; } };
struct BExp { const float* w; const int* panel_e; size_t estride; int ld; int off2;
    DI float operator()(int a, int m0, int k, int n) const { const int e = panel_e[m0 >> 8]; return w[(size_t)e * estride + (size_t)k * ld + n + a * off2]; } };

template <class AF, class BF, class EF, int NACC>
__global__ void __launch_bounds__(256) nv_gemm(AF af, BF bf, EF ef, const int* mlimit, int M, int N, int K, int pad) {
    __shared__ float As[16][65];
    __shared__ float Bs[NACC][16][65];
    const int m0 = blockIdx.y * 64, n0 = blockIdx.x * 64;
    if (mlimit && m0 >= (*mlimit) * 256) return;
    const int tx = threadIdx.x & 15, ty = threadIdx.x >> 4;
    float acc[NACC][4][4];
#pragma unroll
    for (int a = 0; a < NACC; ++a)
#pragma unroll
        for (int i = 0; i < 4; ++i)
#pragma unroll
            for (int j = 0; j < 4; ++j) acc[a][i][j] = 0.f;
    for (int k0 = 0; k0 < K; k0 += 16) {
#pragma unroll
        for (int i = 0; i < 4; ++i) {
            const int t = threadIdx.x + i * 256;
            { const int m = t >> 4, k = t & 15; As[k][m] = af(m0 + m, k0 + k); }
            { const int k = t >> 6, n = t & 63;
#pragma unroll
                for (int a = 0; a < NACC; ++a) Bs[a][k][n] = (n0 + n < N) ? bf(a, m0, k0 + k, n0 + n) : 0.f; }
        }
        __syncthreads();
#pragma unroll
        for (int kk = 0; kk < 16; ++kk) {
            float av[4], bv[NACC][4];
#pragma unroll
            for (int i = 0; i < 4; ++i) av[i] = As[kk][ty * 4 + i];
#pragma unroll
            for (int a = 0; a < NACC; ++a)
#pragma unroll
                for (int j = 0; j < 4; ++j) bv[a][j] = Bs[a][kk][tx * 4 + j];
#pragma unroll
            for (int a = 0; a < NACC; ++a)
#pragma unroll
                for (int i = 0; i < 4; ++i)
#pragma unroll
                    for (int j = 0; j < 4; ++j) acc[a][i][j] += av[i] * bv[a][j];
        }
        __syncthreads();
    }
#pragma unroll
    for (int i = 0; i < 4; ++i)
#pragma unroll
        for (int j = 0; j < 4; ++j) { const int m = m0 + ty * 4 + i, n = n0 + tx * 4 + j; if (n < N) ef(m, n, acc[0][i][j], acc[NACC - 1][i][j]); }
}

struct EInProj {
    unsigned char* ws;
    DI void operator()(int m, int n, float a, float) const {
        bf16_t* QA = (bf16_t*)(ws + WS_QA); bf16_t* KA = (bf16_t*)(ws + WS_KA); bf16_t* QB = (bf16_t*)(ws + WS_QB); bf16_t* KB = (bf16_t*)(ws + WS_KB);
        bf16_t* QC = (bf16_t*)(ws + WS_QC); bf16_t* KC = (bf16_t*)(ws + WS_KC); bf16_t* G = (bf16_t*)(ws + WS_G); bf16_t* VT = (bf16_t*)(ws + WS_VT);
        if (n < 512) QA[(size_t)m * 512 + n] = f2bf(a * C2);
        else if (n < 640) KA[(size_t)m * 128 + (n - 512)] = f2bf(a);
        else if (n < 768) VT[(size_t)(n - 640) * NTOK + m] = f2bf(a);
        else if (n < 1280) QB[(size_t)m * 512 + (n - 768)] = f2bf(a * C2);
        else if (n < 1792) KB[(size_t)m * 512 + (n - 1280)] = f2bf(a);
        else if (n < 2304) VT[(size_t)(128 + n - 1792) * NTOK + m] = f2bf(a);
        else if (n < 2816) QC[(size_t)m * 512 + (n - 2304)] = f2bf(a * C2);
        else if (n < 3328) KC[(size_t)m * 512 + (n - 2816)] = f2bf(a);
        else if (n < 3840) VT[(size_t)(640 + n - 3328) * NTOK + m] = f2bf(a);
        else G[(size_t)m * 3072 + (n - 3840)] = f2bf(sigmoidf_(a));
    }
};
struct EBranch { unsigned char* ws; int i; int pad;
    DI void operator()(int m, int n, float a, float) const {
        const bf16_t* G = (const bf16_t*)(ws + WS_G); float* MF = (float*)(ws + WS_MF); bf16_t* MB = (bf16_t*)(ws + WS_MB);
        float v = bf2f(G[(size_t)m * 3072 + i * 1024 + n]) * a; const size_t idx = (size_t)m * DM + n;
        if (i > 0) v += MF[idx];
        MF[idx] = v; if (i == 2) MB[idx] = f2bf(v);
    }
};
struct EWout { const float* x; float* Y; DI void operator()(int m, int n, float a, float) const { const size_t idx = (size_t)m * DM + n; Y[idx] = DN_ALPHA * x[idx] + a; } };
struct EUp { const float* b_up; const int* panel_e; bf16_t* ACT;
    DI void operator()(int m, int n, float hg, float hl) const {
        const int e = panel_e[m >> 8]; hg += b_up[e * 2048 + n]; hl += b_up[e * 2048 + 1024 + n];
        hg = fminf(hg, SWI_LIMIT); hl = fminf(fmaxf(hl, -SWI_LIMIT), SWI_LIMIT);
        ACT[(size_t)m * FE + n] = f2bf(hg * sigmoidf_(SWI_ALPHA * hg) * (hl + 1.f));
    }
};
struct EDown { const float* b_dn; const int* panel_e; const float* row_w; bf16_t* YS;
    DI void operator()(int m, int n, float a, float) const { const int e = panel_e[m >> 8]; YS[(size_t)m * DM + n] = f2bf((a + b_dn[e * DM + n]) * row_w[m]); }
};

__global__ void __launch_bounds__(256) nv_attn_a(const bf16_t* QA, const bf16_t* KA, const bf16_t* VT, bf16_t* OA, const float* sink) {
    __shared__ float ps[4][320];
    const int w = threadIdx.x >> 6, lane = threadIdx.x & 63;
    const int item = blockIdx.x * 4 + w, tok = item >> 3, h = item & 7, g = h >> 2, b = tok >> 11, s = tok & 2047;
    float q[64]; load_q64(q, QA + (size_t)tok * 512 + h * 64);
    const float slope = exp2f(-8.f * (float)(h + 1) / 12.f) * LOG2E, sk = sink[h] * LOG2E;
    float sc[5]; float mx = sk;
#pragma unroll
    for (int i = 0; i < 5; ++i) {
        const int j = s - 128 + lane + 64 * i; float v = -INFINITY;
        if (j >= 0 && j < SEQ && j <= s + 128) v = dot64_bf(q, KA + (size_t)(b * SEQ + j) * 128 + g * 64) - slope * fabsf((float)(j - s));
        sc[i] = v; mx = fmaxf(mx, v);
    }
    mx = wave_max(mx);
    float l = 0.f;
#pragma unroll
    for (int i = 0; i < 5; ++i) { sc[i] = exp2f(sc[i] - mx); l += sc[i]; }
    l = wave_sum(l) + exp2f(sk - mx);
    const float rl = 1.f / l;
#pragma unroll
    for (int i = 0; i < 5; ++i) ps[w][lane + 64 * i] = sc[i] * rl;
    __syncthreads();
    float o = 0.f; const bf16_t* vp = VT + (size_t)(g * 64 + lane) * NTOK + (size_t)b * SEQ;
    for (int jj = 0; jj < 320; ++jj) { const int j = s - 128 + jj; if (j >= 0 && j < SEQ) o += ps[w][jj] * bf2f(vp[j]); }
    OA[(size_t)tok * 512 + h * 64 + lane] = f2bf(o);
}
__global__ void __launch_bounds__(256) nv_attn_c(const bf16_t* QC, const bf16_t* KC, const bf16_t* VT, bf16_t* OC, const float* rpb  ) {
    __shared__ float ps[4][128];
    const int w = threadIdx.x >> 6, lane = threadIdx.x & 63;
    const int item = blockIdx.x * 4 + w, tok = item >> 3, h = item & 7, b = tok >> 11, s = tok & 2047;
    const int r = s >> 6, qc = s & 63; const int rs = min(max(r - 4, 0), 24), cs = min(max(qc - 8, 0), 48);
    float q[64]; load_q64(q, QC + (size_t)tok * 512 + h * 64);
    float sc[2]; float mx = -INFINITY;
#pragma unroll
    for (int i = 0; i < 2; ++i) {
        const int kk = lane + 64 * i, kr = rs + (kk >> 4), kc = cs + (kk & 15), j = kr * 64 + kc;
        sc[i] = dot64_bf(q, KC + (size_t)(b * SEQ + j) * 512 + h * 64) + rpb[(h * 15 + (kr - r + 7)) * 31 + (kc - qc + 15)] * LOG2E;
        mx = fmaxf(mx, sc[i]);
    }
    mx = wave_max(mx);
    float l = 0.f;
#pragma unroll
    for (int i = 0; i < 2; ++i) { sc[i] = exp2f(sc[i] - mx); l += sc[i]; }
    l = wave_sum(l); const float rl = 1.f / l;
#pragma unroll
    for (int i = 0; i < 2; ++i) ps[w][lane + 64 * i] = sc[i] * rl;
    __syncthreads();
    float o = 0.f; const bf16_t* vp = VT + (size_t)(640 + h * 64 + lane) * NTOK + (size_t)b * SEQ;
    for (int kk = 0; kk < 128; ++kk) { const int j = (rs + (kk >> 4)) * 64 + cs + (kk & 15); o += ps[w][kk] * bf2f(vp[j]); }
    OC[(size_t)tok * 512 + h * 64 + lane] = f2bf(o);
}
__global__ void __launch_bounds__(256) nv_attn_b(const bf16_t* QB, const bf16_t* KB, const bf16_t* VT, bf16_t* OB, const float* lq1, const float* lk1, const float* lq2, const float* lk2,
                                                 const float* gain, float lam_init) {
    __shared__ float as[4][2048];
    const int w = threadIdx.x >> 6, lane = threadIdx.x & 63;
    const int item = blockIdx.x * 4 + w, tok = item >> 2, h = item & 3, b = tok >> 11, s = tok & 2047;
    const float lam = __expf(wave_sum(lq1[lane] * lk1[lane])) - __expf(wave_sum(lq2[lane] * lk2[lane])) + lam_init;
    const float slope = exp2f(-8.f * (float)(8 + h + 1) / 12.f) * LOG2E;
    float p1[32];
    {
        float q[64]; load_q64(q, QB + (size_t)tok * 512 + h * 128);
        float mx = -INFINITY;
#pragma unroll
        for (int i = 0; i < 32; ++i) { const int j = lane + 64 * i; p1[i] = dot64_bf(q, KB + (size_t)(b * SEQ + j) * 512 + h * 128) - slope * fabsf((float)(j - s)); mx = fmaxf(mx, p1[i]); }
        mx = wave_max(mx); float l = 0.f;
#pragma unroll
        for (int i = 0; i < 32; ++i) { p1[i] = exp2f(p1[i] - mx); l += p1[i]; }
        l = wave_sum(l); const float rl = 1.f / l;
#pragma unroll
        for (int i = 0; i < 32; ++i) p1[i] *= rl;
    }
    {
        float q[64]; load_q64(q, QB + (size_t)tok * 512 + h * 128 + 64);
        float p2[32]; float mx = -INFINITY;
#pragma unroll
        for (int i = 0; i < 32; ++i) { const int j = lane + 64 * i; p2[i] = dot64_bf(q, KB + (size_t)(b * SEQ + j) * 512 + h * 128 + 64) - slope * fabsf((float)(j - s)); mx = fmaxf(mx, p2[i]); }
        mx = wave_max(mx); float l = 0.f;
#pragma unroll
        for (int i = 0; i < 32; ++i) { p2[i] = exp2f(p2[i] - mx); l += p2[i]; }
        l = wave_sum(l); const float rl = lam / l;
#pragma unroll
        for (int i = 0; i < 32; ++i) as[w][lane + 64 * i] = p1[i] - p2[i] * rl;
    }
    __syncthreads();
    float o0 = 0.f, o1 = 0.f;
    const bf16_t* v0 = VT + (size_t)(128 + h * 128 + lane) * NTOK + (size_t)b * SEQ; const bf16_t* v1 = v0 + (size_t)64 * NTOK;
    for (int j8 = 0; j8 < 256; ++j8) {
        const u32x4_t a = *(const u32x4_t*)(v0 + 8 * j8), c = *(const u32x4_t*)(v1 + 8 * j8);
#pragma unroll
        for (int i = 0; i < 4; ++i) {
            const float pa = as[w][8 * j8 + 2 * i], pb = as[w][8 * j8 + 2 * i + 1];
            o0 += pa * __uint_as_float(a[i] << 16) + pb * __uint_as_float(a[i] & 0xffff0000u);
            o1 += pa * __uint_as_float(c[i] << 16) + pb * __uint_as_float(c[i] & 0xffff0000u);
        }
    }
    const float ssq = wave_sum(o0 * o0 + o1 * o1), rr = rsqrtf(ssq * (1.f / 128.f) + LN_EPS) * (1.f - lam_init);
    OB[(size_t)tok * 512 + h * 128 + lane] = f2bf(o0 * rr * gain[lane]);
    OB[(size_t)tok * 512 + h * 128 + 64 + lane] = f2bf(o1 * rr * gain[64 + lane]);
}

DI void ln_row(const float* src, const float* g, const float* bta, float* dstF, bf16_t* dstB, int lane) {
    typedef float f4 __attribute__((ext_vector_type(4)));
    f4 v[4]; float s = 0.f;
#pragma unroll
    for (int j = 0; j < 4; ++j) { v[j] = *(const f4*)(src + 256 * j + 4 * lane); s += (v[j].x + v[j].y) + (v[j].z + v[j].w); }
    const float mean = wave_sum(s) * (1.f / DM); float s2 = 0.f;
#pragma unroll
    for (int j = 0; j < 4; ++j) { v[j] = v[j] - mean; s2 += (v[j].x * v[j].x + v[j].y * v[j].y) + (v[j].z * v[j].z + v[j].w * v[j].w); }
    const float rstd = rsqrtf(wave_sum(s2) * (1.f / DM) + LN_EPS);
#pragma unroll
    for (int j = 0; j < 4; ++j) {
        const f4 gg = *(const f4*)(g + 256 * j + 4 * lane), bb = *(const f4*)(bta + 256 * j + 4 * lane);
        const f4 o = v[j] * rstd * gg + bb;
        *(f4*)(dstF + 256 * j + 4 * lane) = o;
        if (dstB) { uint2 pk; pk.x = (unsigned)f2bf(o.x) | ((unsigned)f2bf(o.y) << 16); pk.y = (unsigned)f2bf(o.z) | ((unsigned)f2bf(o.w) << 16); *(uint2*)(dstB + 256 * j + 4 * lane) = pk; }
    }
}
DI void topk_token(const float* lg, int* ti, float* tw) {
    float v[32];
#pragma unroll
    for (int e = 0; e < 32; ++e) v[e] = lg[e];
    int idx[4]; float val[4];
#pragma unroll
    for (int k = 0; k < 4; ++k) {
        float best = -INFINITY; int bi = 0;
#pragma unroll
        for (int e = 0; e < 32; ++e) { const bool taken = (k > 0 && idx[0] == e) || (k > 1 && idx[1] == e) || (k > 2 && idx[2] == e); if (!taken && v[e] > best) { best = v[e]; bi = e; } }
        idx[k] = bi; val[k] = best;
    }
    float l = 0.f, ex[4];
#pragma unroll
    for (int k = 0; k < 4; ++k) { ex[k] = __expf(val[k] - val[0]); l += ex[k]; }
#pragma unroll
    for (int k = 0; k < 4; ++k) { ti[k] = idx[k]; tw[k] = ex[k] / l; }
}
DI void hist_block(const int* topi, int* hist, int vb, int* lds_hist) {
    if (threadIdx.x < 32) lds_hist[threadIdx.x] = 0;
    __syncthreads();
    for (int a = threadIdx.x; a < 256; a += blockDim.x) atomicAdd(&lds_hist[topi[vb * 256 + a]], 1);
    __syncthreads();
    if (threadIdx.x < 32) hist[vb * 32 + threadIdx.x] = lds_hist[threadIdx.x];
    __syncthreads();
}
DI void dispatch_block(unsigned char* ws, int vb, int* lds) {
    const int* hist = (const int*)(ws + WS_HIST); const int* topi = (const int*)(ws + WS_TOPI); const float* topw = (const float*)(ws + WS_TOPW);
    int* tslot = (int*)(ws + WS_TSLOT); int* rtok = (int*)(ws + WS_RTOK); float* rw = (float*)(ws + WS_RW); int* pane = (int*)(ws + WS_PANE);
    int* cnt = lds, *base = lds + 32, *pstart = lds + 64, *npan = lds + 96;
    if (threadIdx.x < 32) { const int e = threadIdx.x; int c = 0, bsum = 0; for (int b2 = 0; b2 < NRB; ++b2) { const int hv = hist[b2 * 32 + e]; c += hv; if (b2 < vb) bsum += hv; } cnt[e] = c; base[e] = bsum; }
    __syncthreads();
    if (threadIdx.x == 0) { int acc = 0; for (int e = 0; e < 32; ++e) { pstart[e] = acc; acc += ((cnt[e] + 255) >> 8) << 8; } npan[0] = acc >> 8; }
    __syncthreads();
    if (threadIdx.x < 32) {
        const int e = threadIdx.x; int slot = pstart[e] + base[e];
        for (int a = 0; a < 256; ++a) { if (topi[vb * 256 + a] == e) { tslot[vb * 256 + a] = slot; rtok[slot] = vb * 64 + (a >> 2); rw[slot] = topw[vb * 256 + a]; ++slot; } }
        if (vb == 0) { const int p0 = pstart[e] >> 8, p1 = p0 + ((cnt[e] + 255) >> 8); for (int p = p0; p < p1; ++p) pane[p] = e; if (e == 0) pane[511] = npan[0]; }
    }
    __syncthreads();
    const bf16_t* x1b = (const bf16_t*)(ws + WS_X1B); bf16_t* xs = (bf16_t*)(ws + WS_XS);
    for (int i = threadIdx.x; i < 256 * 128; i += blockDim.x) {
        const int a = i >> 7, c = i & 127; const int slot = tslot[vb * 256 + a];
        *(u32x4_t*)(xs + (size_t)slot * DM + 8 * c) = *(const u32x4_t*)(x1b + (size_t)(vb * 64 + (a >> 2)) * DM + 8 * c);
    }
    __syncthreads();
}
DI void combine_row(unsigned char* ws, int tok, const float* g, const float* bta, float* outF, bf16_t* outB, int lane) {
    typedef float f4 __attribute__((ext_vector_type(4)));
    const float* x1 = (const float*)(ws + WS_X1F) + (size_t)tok * DM; const bf16_t* ys = (const bf16_t*)(ws + WS_YS); const int* tslot = (const int*)(ws + WS_TSLOT) + tok * 4;
    f4 v[4]; float s = 0.f;
#pragma unroll
    for (int j = 0; j < 4; ++j) v[j] = *(const f4*)(x1 + 256 * j + 4 * lane) * DN_ALPHA;
#pragma unroll
    for (int k = 0; k < 4; ++k) { const bf16_t* yr = ys + (size_t)tslot[k] * DM;
#pragma unroll
        for (int j = 0; j < 4; ++j) { const uint2 pk = *(const uint2*)(yr + 256 * j + 4 * lane);
            v[j].x += __uint_as_float(pk.x << 16); v[j].y += __uint_as_float(pk.x & 0xffff0000u); v[j].z += __uint_as_float(pk.y << 16); v[j].w += __uint_as_float(pk.y & 0xffff0000u); } }
#pragma unroll
    for (int j = 0; j < 4; ++j) s += (v[j].x + v[j].y) + (v[j].z + v[j].w);
    const float mean = wave_sum(s) * (1.f / DM); float s2 = 0.f;
#pragma unroll
    for (int j = 0; j < 4; ++j) { v[j] = v[j] - mean; s2 += (v[j].x * v[j].x + v[j].y * v[j].y) + (v[j].z * v[j].z + v[j].w * v[j].w); }
    const float rstd = rsqrtf(wave_sum(s2) * (1.f / DM) + LN_EPS);
#pragma unroll
    for (int j = 0; j < 4; ++j) {
        const f4 gg = *(const f4*)(g + 256 * j + 4 * lane), bb = *(const f4*)(bta + 256 * j + 4 * lane);
        const f4 o = v[j] * rstd * gg + bb;
        *(f4*)(outF + (size_t)tok * DM + 256 * j + 4 * lane) = o;
        if (outB) { uint2 pk; pk.x = (unsigned)f2bf(o.x) | ((unsigned)f2bf(o.y) << 16); pk.y = (unsigned)f2bf(o.z) | ((unsigned)f2bf(o.w) << 16); *(uint2*)(outB + (size_t)tok * DM + 256 * j + 4 * lane) = pk; }
    }
}

__global__ void __launch_bounds__(256) k_ln1(const float* Y, const float* g, const float* b, float* X1F, bf16_t* X1B) {
    const int row = blockIdx.x * 4 + (threadIdx.x >> 6); ln_row(Y + (size_t)row * DM, g, b, X1F + (size_t)row * DM, X1B + (size_t)row * DM, threadIdx.x & 63);
}
__global__ void __launch_bounds__(256) k_router_naive(const float* X1F, const float* wr, const float* br, float* logits) {
    const int gid = blockIdx.x * 256 + threadIdx.x, tok = gid >> 5, e = gid & 31; const float* x = X1F + (size_t)tok * DM; float acc = 0.f;
    for (int k = 0; k < DM; ++k) acc += x[k] * wr[k * 32 + e];
    logits[gid] = acc + br[e];
}
__global__ void __launch_bounds__(256) k_topk(const float* logits, int* ti, float* tw) { const int tok = blockIdx.x * 256 + threadIdx.x; topk_token(logits + tok * 32, ti + tok * 4, tw + tok * 4); }
__global__ void __launch_bounds__(256) k_hist(unsigned char* ws) { __shared__ int lh[32]; hist_block((const int*)(ws + WS_TOPI), (int*)(ws + WS_HIST), blockIdx.x, lh); }
__global__ void __launch_bounds__(256) k_dispatch(unsigned char* ws) { __shared__ int l[128]; dispatch_block(ws, blockIdx.x, l); }
__global__ void __launch_bounds__(256) k_combine(unsigned char* ws, const float* g, const float* b, float* outF, bf16_t* outB) {
    const int tok = blockIdx.x * 4 + (threadIdx.x >> 6); combine_row(ws, tok, g, b, outF, outB, threadIdx.x & 63);
}

extern "C" void kernel_launch(void* const* d_in, const int* in_sizes, int n_in, void* d_out, int out_size, void* d_ws, size_t ws_size, hipStream_t stream) {
    if (n_in != 21 || ws_size < WS_END) { fprintf(stderr, "kernel_launch: unexpected inputs (n_in %d, ws %zu)\n", n_in, ws_size); return; }
    unsigned char* ws = (unsigned char*)d_ws;
    const float* x_in = (const float*)d_in[0];
    hipMemsetAsync(ws + WS_CTL, 0, 1 * MiB, stream);
    for (int l = 0; l < 2; ++l) {
        const float* xcur = l == 0 ? x_in : (const float*)(ws + WS_XF);
        float* xnext = l == 0 ? (float*)(ws + WS_XF) : (float*)d_out;
        const float* w_in = (const float*)d_in[1] + (size_t)l * DM * IN_W;
        const float* a_sink = (const float*)d_in[2] + l * 8;
        const float* lq1 = (const float*)d_in[3] + l * 64; const float* lk1 = (const float*)d_in[4] + l * 64;
        const float* lq2 = (const float*)d_in[5] + l * 64; const float* lk2 = (const float*)d_in[6] + l * 64;
        const float* dng = (const float*)d_in[7] + l * 128;
        const float* rpb = (const float*)d_in[8] + (size_t)l * 8 * 15 * 31;
        const float* w_br = (const float*)d_in[9] + (size_t)l * 3 * 512 * DM;
        const float* w_out = (const float*)d_in[10] + (size_t)l * DM * DM;
        const float* ln1g = (const float*)d_in[11] + l * DM; const float* ln1b = (const float*)d_in[12] + l * DM;
        const float* w_r = (const float*)d_in[13] + (size_t)l * DM * 32; const float* b_r = (const float*)d_in[14] + l * 32;
        const float* w_up = (const float*)d_in[15] + (size_t)l * NE * DM * 2048; const float* b_up = (const float*)d_in[16] + (size_t)l * NE * 2048;
        const float* w_dn = (const float*)d_in[17] + (size_t)l * NE * FE * DM; const float* b_dn = (const float*)d_in[18] + (size_t)l * NE * DM;
        const float* ln2g = (const float*)d_in[19] + l * DM; const float* ln2b = (const float*)d_in[20] + l * DM;
        const float lam_init = 0.8f - 0.6f * expf(-0.3f * (float)l);
        nv_gemm<AF32, BKN, EInProj, 1><<<dim3(IN_W / 64, NTOK / 64), 256, 0, stream>>>(AF32{xcur, DM}, BKN{w_in, IN_W, 0}, EInProj{ws}, nullptr, NTOK, IN_W, DM, 0);
        nv_attn_a<<<NTOK * 8 / 4, 256, 0, stream>>>((const bf16_t*)(ws + WS_QA), (const bf16_t*)(ws + WS_KA), (const bf16_t*)(ws + WS_VT), (bf16_t*)(ws + WS_BR), a_sink);
        nv_attn_b<<<NTOK * 4 / 4, 256, 0, stream>>>((const bf16_t*)(ws + WS_QB), (const bf16_t*)(ws + WS_KB), (const bf16_t*)(ws + WS_VT), (bf16_t*)(ws + WS_BR) + (size_t)NTOK * 512, lq1, lk1, lq2, lk2, dng, lam_init);
        nv_attn_c<<<NTOK * 8 / 4, 256, 0, stream>>>((const bf16_t*)(ws + WS_QC), (const bf16_t*)(ws + WS_KC), (const bf16_t*)(ws + WS_VT), (bf16_t*)(ws + WS_BR) + (size_t)2 * NTOK * 512, rpb);
        for (int i = 0; i < 3; ++i)
            nv_gemm<ABF, BKN, EBranch, 1><<<dim3(DM / 64, NTOK / 64), 256, 0, stream>>>(ABF{(const bf16_t*)(ws + WS_BR) + (size_t)i * NTOK * 512, 512}, BKN{w_br + (size_t)i * 512 * DM, DM, 0}, EBranch{ws, i}, nullptr, NTOK, DM, 512, 0);
        nv_gemm<AF32, BKN, EWout, 1><<<dim3(DM / 64, NTOK / 64), 256, 0, stream>>>(AF32{(const float*)(ws + WS_MF), DM}, BKN{w_out, DM, 0}, EWout{xcur, (float*)(ws + WS_Y)}, nullptr, NTOK, DM, DM, 0);
        k_ln1<<<NTOK / 4, 256, 0, stream>>>((const float*)(ws + WS_Y), ln1g, ln1b, (float*)(ws + WS_X1F), (bf16_t*)(ws + WS_X1B));
        k_router_naive<<<NTOK * 32 / 256, 256, 0, stream>>>((const float*)(ws + WS_X1F), w_r, b_r, (float*)(ws + WS_LOGIT));
        k_topk<<<NTOK / 256, 256, 0, stream>>>((const float*)(ws + WS_LOGIT), (int*)(ws + WS_TOPI), (float*)(ws + WS_TOPW));
        k_hist<<<NRB, 256, 0, stream>>>(ws);
        hipMemsetAsync(ws + WS_RTOK, 0xFF, NPADROWS * 4, stream);
        k_dispatch<<<NRB, 256, 0, stream>>>(ws);
        nv_gemm<AGather, BExp, EUp, 2><<<dim3(FE / 64, NPADROWS / 64), 256, 0, stream>>>(AGather{(const float*)(ws + WS_X1F), (const int*)(ws + WS_RTOK)},
            BExp{w_up, (const int*)(ws + WS_PANE), (size_t)DM * 2048, 2048, 1024}, EUp{b_up, (const int*)(ws + WS_PANE), (bf16_t*)(ws + WS_ACTB)}, (const int*)(ws + WS_PANE) + 511, NPADROWS, FE, DM, 0);
        nv_gemm<ABF, BExp, EDown, 1><<<dim3(DM / 64, NPADROWS / 64), 256, 0, stream>>>(ABF{(const bf16_t*)(ws + WS_ACTB), FE},
            BExp{w_dn, (const int*)(ws + WS_PANE), (size_t)FE * DM, DM, 0}, EDown{b_dn, (const int*)(ws + WS_PANE), (const float*)(ws + WS_RW), (bf16_t*)(ws + WS_YS)}, (const int*)(ws + WS_PANE) + 511, NPADROWS, DM, FE, 0);
        k_combine<<<NTOK / 4, 256, 0, stream>>>(ws, ln2g, ln2b, xnext, l == 0 ? (bf16_t*)(ws + WS_XB) : nullptr);
    }
}
```

```cpp
#include <hip/hip_runtime.h>
#include <stdint.h>
#include <stdio.h>

#define DI __device__ __forceinline__
typedef unsigned short bf16_t;
typedef unsigned u32x4_t __attribute__((ext_vector_type(4)));

constexpr int NTOK = 16384, DM = 1024, SEQ = 2048, NBATCH = 8;
constexpr int IN_W = 6912;
constexpr int NE = 32, TOPK = 4, FE = 1024;
constexpr int MAXPANELS = 288;
constexpr int NPADROWS = MAXPANELS * 256;
constexpr float LOG2E = 1.4426950408889634f;
constexpr float C2 = 0.125f * 1.4426950408889634f;
constexpr float DN_ALPHA = 1.4142135623730951f;
constexpr float LN_EPS = 1e-5f;
constexpr float SWI_LIMIT = 7.0f, SWI_ALPHA = 1.702f;
constexpr int NRB = 256;

constexpr size_t MiB = 1u << 20;
constexpr size_t WS_CTL = 0;
constexpr size_t WS_TOPI = 1 * MiB;
constexpr size_t WS_TOPW = WS_TOPI + 256 * 1024;
constexpr size_t WS_TSLOT = WS_TOPW + 256 * 1024;
constexpr size_t WS_RTOK = WS_TSLOT + 256 * 1024;
constexpr size_t WS_RW = WS_RTOK + 512 * 1024;
constexpr size_t WS_HIST = WS_RW + 512 * 1024;
constexpr size_t WS_PANE = WS_HIST + 64 * 1024;
constexpr size_t WS_LOGIT = 4 * MiB;
constexpr size_t WS_W = 8 * MiB;
constexpr size_t WL_IN = 0, WL_OUT = 14 * MiB, WL_BR = 16 * MiB, WL_UP = 19 * MiB, WL_DN = 147 * MiB, WL_BYTES = 211 * MiB;
constexpr size_t WS_ACT = WS_W + 2 * WL_BYTES;
constexpr size_t WS_XB = WS_ACT;
constexpr size_t WS_XF = WS_XB + 32 * MiB;
constexpr size_t WS_QA = WS_XF + 64 * MiB;
constexpr size_t WS_KA = WS_QA + 16 * MiB;
constexpr size_t WS_QB = WS_KA + 4 * MiB;
constexpr size_t WS_KB = WS_QB + 16 * MiB;
constexpr size_t WS_QC = WS_KB + 16 * MiB;
constexpr size_t WS_KC = WS_QC + 16 * MiB;
constexpr size_t WS_G = WS_KC + 16 * MiB;
constexpr size_t WS_VT = WS_G + 96 * MiB;
constexpr size_t WS_BR = WS_VT + 40 * MiB;
constexpr size_t WS_MF = WS_BR + 48 * MiB;
constexpr size_t WS_MB = WS_MF + 64 * MiB;
constexpr size_t WS_Y = WS_MB + 32 * MiB;
constexpr size_t WS_X1F = WS_Y + 64 * MiB;
constexpr size_t WS_X1B = WS_X1F + 64 * MiB;
constexpr size_t WS_XS = WS_X1B + 32 * MiB;
constexpr size_t WS_ACTB = WS_XS + 144 * MiB;
constexpr size_t WS_YS = WS_ACTB + 144 * MiB;
constexpr size_t WS_END = WS_YS + 144 * MiB;
static_assert(WS_END <= 2048 * MiB, "workspace map");

DI float bf2f(bf16_t v) { return __uint_as_float(((unsigned)v) << 16); }
DI bf16_t f2bf(float f) { unsigned u = __float_as_uint(f); return (bf16_t)((u + 0x7fffu + ((u >> 16) & 1u)) >> 16); }
DI float wave_sum(float v) {
#pragma unroll
    for (int o = 1; o < 64; o <<= 1) v += __shfl_xor(v, o);
    return v;
}
DI float wave_max(float v) {
#pragma unroll
    for (int o = 1; o < 64; o <<= 1) v = fmaxf(v, __shfl_xor(v, o));
    return v;
}
DI float sigmoidf_(float x) { return 1.f / (1.f + __expf(-x)); }
DI float dot64_bf(const float (&q)[64], const bf16_t* kp) {
    float acc = 0.f;
#pragma unroll
    for (int c = 0; c < 8; ++c) {
        const u32x4_t v = *(const u32x4_t*)(kp + 8 * c);
#pragma unroll
        for (int i = 0; i < 4; ++i) {
            acc += q[8 * c + 2 * i] * __uint_as_float(v[i] << 16);
            acc += q[8 * c + 2 * i + 1] * __uint_as_float(v[i] & 0xffff0000u);
        }
    }
    return acc;
}
DI void load_q64(float (&q)[64], const bf16_t* qp) {
#pragma unroll
    for (int c = 0; c < 8; ++c) {
        const u32x4_t v = *(const u32x4_t*)(qp + 8 * c);
#pragma unroll
        for (int i = 0; i < 4; ++i) { q[8 * c + 2 * i] = __uint_as_float(v[i] << 16); q[8 * c + 2 * i + 1] = __uint_as_float(v[i] & 0xffff0000u); }
    }
}

struct AF32 { const float* p; int ld; int pad; DI float operator()(int m, int k) const { return p[(size_t)m * ld + k]; } };
struct ABF { const bf16_t* p; int ld; int pad; DI float operator()(int m, int k) const { return bf2f(p[(size_t)m * ld + k]); } };
struct AGather { const float* x; const int* row_tok; DI float operator()(int m, int k) const { const int t = row_tok[m]; return (t < 0 || t >= NTOK) ? 0.f : x[(size_t)t * DM + k]; } };
struct BKN { const float* p; int ld; int off2; DI float operator()(int a, int, int k, int n) const { return p[(size_t)k * ld + n + a * off2]; } };
struct BExp { const float* w; const int* panel_e; size_t estride; int ld; int off2;
    DI float operator()(int a, int m0, int k, int n) const { const int e = panel_e[m0 >> 8]; return w[(size_t)e * estride + (size_t)k * ld + n + a * off2]; } };

template <class AF, class BF, class EF, int NACC>
__global__ void __launch_bounds__(256) nv_gemm(AF af, BF bf, EF ef, const int* mlimit, int M, int N, int K, int pad) {
    __shared__ float As[16][65];
    __shared__ float Bs[NACC][16][65];
    const int m0 = blockIdx.y * 64, n0 = blockIdx.x * 64;
    if (mlimit && m0 >= (*mlimit) * 256) return;
    const int tx = threadIdx.x & 15, ty = threadIdx.x >> 4;
    float acc[NACC][4][4];
#pragma unroll
    for (int a = 0; a < NACC; ++a)
#pragma unroll
        for (int i = 0; i < 4; ++i)
#pragma unroll
            for (int j = 0; j < 4; ++j) acc[a][i][j] = 0.f;
    for (int k0 = 0; k0 < K; k0 += 16) {
#pragma unroll
        for (int i = 0; i < 4; ++i) {
            const int t = threadIdx.x + i * 256;
            { const int m = t >> 4, k = t & 15; As[k][m] = af(m0 + m, k0 + k); }
            { const int k = t >> 6, n = t & 63;
#pragma unroll
                for (int a = 0; a < NACC; ++a) Bs[a][k][n] = (n0 + n < N) ? bf(a, m0, k0 + k, n0 + n) : 0.f; }
        }
        __syncthreads();
#pragma unroll
        for (int kk = 0; kk < 16; ++kk) {
            float av[4], bv[NACC][4];
#pragma unroll
            for (int i = 0; i < 4; ++i) av[i] = As[kk][ty * 4 + i];
#pragma unroll
            for (int a = 0; a < NACC; ++a)
#pragma unroll
                for (int j = 0; j < 4; ++j) bv[a][j] = Bs[a][kk][tx * 4 + j];
#pragma unroll
            for (int a = 0; a < NACC; ++a)
#pragma unroll
                for (int i = 0; i < 4; ++i)
#pragma unroll
                    for (int j = 0; j < 4; ++j) acc[a][i][j] += av[i] * bv[a][j];
        }
        __syncthreads();
    }
#pragma unroll
    for (int i = 0; i < 4; ++i)
#pragma unroll
        for (int j = 0; j < 4; ++j) { const int m = m0 + ty * 4 + i, n = n0 + tx * 4 + j; if (n < N) ef(m, n, acc[0][i][j], acc[NACC - 1][i][j]); }
}

struct EInProj {
    unsigned char* ws;
    DI void operator()(int m, int n, float a, float) const {
        bf16_t* QA = (bf16_t*)(ws + WS_QA); bf16_t* KA = (bf16_t*)(ws + WS_KA); bf16_t* QB = (bf16_t*)(ws + WS_QB); bf16_t* KB = (bf16_t*)(ws + WS_KB);
        bf16_t* QC = (bf16_t*)(ws + WS_QC); bf16_t* KC = (bf16_t*)(ws + WS_KC); bf16_t* G = (bf16_t*)(ws + WS_G); bf16_t* VT = (bf16_t*)(ws + WS_VT);
        if (n < 512) QA[(size_t)m * 512 + n] = f2bf(a * C2);
        else if (n < 640) KA[(size_t)m * 128 + (n - 512)] = f2bf(a);
        else if (n < 768) VT[(size_t)(n - 640) * NTOK + m] = f2bf(a);
        else if (n < 1280) QB[(size_t)m * 512 + (n - 768)] = f2bf(a * C2);
        else if (n < 1792) KB[(size_t)m * 512 + (n - 1280)] = f2bf(a);
        else if (n < 2304) VT[(size_t)(128 + n - 1792) * NTOK + m] = f2bf(a);
        else if (n < 2816) QC[(size_t)m * 512 + (n - 2304)] = f2bf(a * C2);
        else if (n < 3328) KC[(size_t)m * 512 + (n - 2816)] = f2bf(a);
        else if (n < 3840) VT[(size_t)(640 + n - 3328) * NTOK + m] = f2bf(a);
        else G[(size_t)m * 3072 + (n - 3840)] = f2bf(sigmoidf_(a));
    }
};
struct EBranch { unsigned char* ws; int i; int pad;
    DI void operator()(int m, int n, float a, float) const {
        const bf16_t* G = (const bf16_t*)(ws + WS_G); float* MF = (float*)(ws + WS_MF); bf16_t* MB = (bf16_t*)(ws + WS_MB);
        float v = bf2f(G[(size_t)m * 3072 + i * 1024 + n]) * a; const size_t idx = (size_t)m * DM + n;
        if (i > 0) v += MF[idx];
        MF[idx] = v; if (i == 2) MB[idx] = f2bf(v);
    }
};
struct EWout { const float* x; float* Y; DI void operator()(int m, int n, float a, float) const { const size_t idx = (size_t)m * DM + n; Y[idx] = DN_ALPHA * x[idx] + a; } };
struct EUp { const float* b_up; const int* panel_e; bf16_t* ACT;
    DI void operator()(int m, int n, float hg, float hl) const {
        const int e = panel_e[m >> 8]; hg += b_up[e * 2048 + n]; hl += b_up[e * 2048 + 1024 + n];
        hg = fminf(hg, SWI_LIMIT); hl = fminf(fmaxf(hl, -SWI_LIMIT), SWI_LIMIT);
        ACT[(size_t)m * FE + n] = f2bf(hg * sigmoidf_(SWI_ALPHA * hg) * (hl + 1.f));
    }
};
struct EDown { const float* b_dn; const int* panel_e; const float* row_w; bf16_t* YS;
    DI void operator()(int m, int n, float a, float) const { const int e = panel_e[m >> 8]; YS[(size_t)m * DM + n] = f2bf((a + b_dn[e * DM + n]) * row_w[m]); }
};

__global__ void __launch_bounds__(256) nv_attn_a(const bf16_t* QA, const bf16_t* KA, const bf16_t* VT, bf16_t* OA, const float* sink) {
    __shared__ float ps[4][320];
    const int w = threadIdx.x >> 6, lane = threadIdx.x & 63;
    const int item = blockIdx.x * 4 + w, tok = item >> 3, h = item & 7, g = h >> 2, b = tok >> 11, s = tok & 2047;
    float q[64]; load_q64(q, QA + (size_t)tok * 512 + h * 64);
    const float slope = exp2f(-8.f * (float)(h + 1) / 12.f) * LOG2E, sk = sink[h] * LOG2E;
    float sc[5]; float mx = sk;
#pragma unroll
    for (int i = 0; i < 5; ++i) {
        const int j = s - 128 + lane + 64 * i; float v = -INFINITY;
        if (j >= 0 && j < SEQ && j <= s + 128) v = dot64_bf(q, KA + (size_t)(b * SEQ + j) * 128 + g * 64) - slope * fabsf((float)(j - s));
        sc[i] = v; mx = fmaxf(mx, v);
    }
    mx = wave_max(mx);
    float l = 0.f;
#pragma unroll
    for (int i = 0; i < 5; ++i) { sc[i] = exp2f(sc[i] - mx); l += sc[i]; }
    l = wave_sum(l) + exp2f(sk - mx);
    const float rl = 1.f / l;
#pragma unroll
    for (int i = 0; i < 5; ++i) ps[w][lane + 64 * i] = sc[i] * rl;
    __syncthreads();
    float o = 0.f; const bf16_t* vp = VT + (size_t)(g * 64 + lane) * NTOK + (size_t)b * SEQ;
    for (int jj = 0; jj < 320; ++jj) { const int j = s - 128 + jj; if (j >= 0 && j < SEQ) o += ps[w][jj] * bf2f(vp[j]); }
    OA[(size_t)tok * 512 + h * 64 + lane] = f2bf(o);
}
__global__ void __launch_bounds__(256) nv_attn_c(const bf16_t* QC, const bf16_t* KC, const bf16_t* VT, bf16_t* OC, const float* rpb  ) {
    __shared__ float ps[4][128];
    const int w = threadIdx.x >> 6, lane = threadIdx.x & 63;
    const int item = blockIdx.x * 4 + w, tok = item >> 3, h = item & 7, b = tok >> 11, s = tok & 2047;
    const int r = s >> 6, qc = s & 63; const int rs = min(max(r - 4, 0), 24), cs = min(max(qc - 8, 0), 48);
    float q[64]; load_q64(q, QC + (size_t)tok * 512 + h * 64);
    float sc[2]; float mx = -INFINITY;
#pragma unroll
    for (int i = 0; i < 2; ++i) {
        const int kk = lane + 64 * i, kr = rs + (kk >> 4), kc = cs + (kk & 15), j = kr * 64 + kc;
        sc[i] = dot64_bf(q, KC + (size_t)(b * SEQ + j) * 512 + h * 64) + rpb[(h * 15 + (kr - r + 7)) * 31 + (kc - qc + 15)] * LOG2E;
        mx = fmaxf(mx, sc[i]);
    }
    mx = wave_max(mx);
    float l = 0.f;
#pragma unroll
    for (int i = 0; i < 2; ++i) { sc[i] = exp2f(sc[i] - mx); l += sc[i]; }
    l = wave_sum(l); const float rl = 1.f / l;
#pragma unroll
    for (int i = 0; i < 2; ++i) ps[w][lane + 64 * i] = sc[i] * rl;
    __syncthreads();
    float o = 0.f; const bf16_t* vp = VT + (size_t)(640 + h * 64 + lane) * NTOK + (size_t)b * SEQ;
    for (int kk = 0; kk < 128; ++kk) { const int j = (rs + (kk >> 4)) * 64 + cs + (kk & 15); o += ps[w][kk] * bf2f(vp[j]); }
    OC[(size_t)tok * 512 + h * 64 + lane] = f2bf(o);
}
__global__ void __launch_bounds__(256) nv_attn_b(const bf16_t* QB, const bf16_t* KB, const bf16_t* VT, bf16_t* OB, const float* lq1, const float* lk1, const float* lq2, const float* lk2,
                                                 const float* gain, float lam_init) {
    __shared__ float as[4][2048];
    const int w = threadIdx.x >> 6, lane = threadIdx.x & 63;
    const int item = blockIdx.x * 4 + w, tok = item >> 2, h = item & 3, b = tok >> 11, s = tok & 2047;
    const float lam = __expf(wave_sum(lq1[lane] * lk1[lane])) - __expf(wave_sum(lq2[lane] * lk2[lane])) + lam_init;
    const float slope = exp2f(-8.f * (float)(8 + h + 1) / 12.f) * LOG2E;
    float p1[32];
    {
        float q[64]; load_q64(q, QB + (size_t)tok * 512 + h * 128);
        float mx = -INFINITY;
#pragma unroll
        for (int i = 0; i < 32; ++i) { const int j = lane + 64 * i; p1[i] = dot64_bf(q, KB + (size_t)(b * SEQ + j) * 512 + h * 128) - slope * fabsf((float)(j - s)); mx = fmaxf(mx, p1[i]); }
        mx = wave_max(mx); float l = 0.f;
#pragma unroll
        for (int i = 0; i < 32; ++i) { p1[i] = exp2f(p1[i] - mx); l += p1[i]; }
        l = wave_sum(l); const float rl = 1.f / l;
#pragma unroll
        for (int i = 0; i < 32; ++i) p1[i] *= rl;
    }
    {
        float q[64]; load_q64(q, QB + (size_t)tok * 512 + h * 128 + 64);
        float p2[32]; float mx = -INFINITY;
#pragma unroll
        for (int i = 0; i < 32; ++i) { const int j = lane + 64 * i; p2[i] = dot64_bf(q, KB + (size_t)(b * SEQ + j) * 512 + h * 128 + 64) - slope * fabsf((float)(j - s)); mx = fmaxf(mx, p2[i]); }
        mx = wave_max(mx); float l = 0.f;
#pragma unroll
        for (int i = 0; i < 32; ++i) { p2[i] = exp2f(p2[i] - mx); l += p2[i]; }
        l = wave_sum(l); const float rl = lam / l;
#pragma unroll
        for (int i = 0; i < 32; ++i) as[w][lane + 64 * i] = p1[i] - p2[i] * rl;
    }
    __syncthreads();
    float o0 = 0.f, o1 = 0.f;
    const bf16_t* v0 = VT + (size_t)(128 + h * 128 + lane) * NTOK + (size_t)b * SEQ; const bf16_t* v1 = v0 + (size_t)64 * NTOK;
    for (int j8 = 0; j8 < 256; ++j8) {
        const u32x4_t a = *(const u32x4_t*)(v0 + 8 * j8), c = *(const u32x4_t*)(v1 + 8 * j8);
#pragma unroll
        for (int i = 0; i < 4; ++i) {
            const float pa = as[w][8 * j8 + 2 * i], pb = as[w][8 * j8 + 2 * i + 1];
            o0 += pa * __uint_as_float(a[i] << 16) + pb * __uint_as_float(a[i] & 0xffff0000u);
            o1 += pa * __uint_as_float(c[i] << 16) + pb * __uint_as_float(c[i] & 0xffff0000u);
        }
    }
    const float ssq = wave_sum(o0 * o0 + o1 * o1), rr = rsqrtf(ssq * (1.f / 128.f) + LN_EPS) * (1.f - lam_init);
    OB[(size_t)tok * 512 + h * 128 + lane] = f2bf(o0 * rr * gain[lane]);
    OB[(size_t)tok * 512 + h * 128 + 64 + lane] = f2bf(o1 * rr * gain[64 + lane]);
}

DI void ln_row(const float* src, const float* g, const float* bta, float* dstF, bf16_t* dstB, int lane) {
    typedef float f4 __attribute__((ext_vector_type(4)));
    f4 v[4]; float s = 0.f;
#pragma unroll
    for (int j = 0; j < 4; ++j) { v[j] = *(const f4*)(src + 256 * j + 4 * lane); s += (v[j].x + v[j].y) + (v[j].z + v[j].w); }
    const float mean = wave_sum(s) * (1.f / DM); float s2 = 0.f;
#pragma unroll
    for (int j = 0; j < 4; ++j) { v[j] = v[j] - mean; s2 += (v[j].x * v[j].x + v[j].y * v[j].y) + (v[j].z * v[j].z + v[j].w * v[j].w); }
    const float rstd = rsqrtf(wave_sum(s2) * (1.f / DM) + LN_EPS);
#pragma unroll
    for (int j = 0; j < 4; ++j) {
        const f4 gg = *(const f4*)(g + 256 * j + 4 * lane), bb = *(const f4*)(bta + 256 * j + 4 * lane);
        const f4 o = v[j] * rstd * gg + bb;
        *(f4*)(dstF + 256 * j + 4 * lane) = o;
        if (dstB) { uint2 pk; pk.x = (unsigned)f2bf(o.x) | ((unsigned)f2bf(o.y) << 16); pk.y = (unsigned)f2bf(o.z) | ((unsigned)f2bf(o.w) << 16); *(uint2*)(dstB + 256 * j + 4 * lane) = pk; }
    }
}
DI void topk_token(const float* lg, int* ti, float* tw) {
    float v[32];
#pragma unroll
    for (int e = 0; e < 32; ++e) v[e] = lg[e];
    int idx[4]; float val[4];
#pragma unroll
    for (int k = 0; k < 4; ++k) {
        float best = -INFINITY; int bi = 0;
#pragma unroll
        for (int e = 0; e < 32; ++e) { const bool taken = (k > 0 && idx[0] == e) || (k > 1 && idx[1] == e) || (k > 2 && idx[2] == e); if (!taken && v[e] > best) { best = v[e]; bi = e; } }
        idx[k] = bi; val[k] = best;
    }
    float l = 0.f, ex[4];
#pragma unroll
    for (int k = 0; k < 4; ++k) { ex[k] = __expf(val[k] - val[0]); l += ex[k]; }
#pragma unroll
    for (int k = 0; k < 4; ++k) { ti[k] = idx[k]; tw[k] = ex[k] / l; }
}
DI void hist_block(const int* topi, int* hist, int vb, int* lds_hist) {
    if (threadIdx.x < 32) lds_hist[threadIdx.x] = 0;
    __syncthreads();
    for (int a = threadIdx.x; a < 256; a += blockDim.x) atomicAdd(&lds_hist[topi[vb * 256 + a]], 1);
    __syncthreads();
    if (threadIdx.x < 32) hist[vb * 32 + threadIdx.x] = lds_hist[threadIdx.x];
    __syncthreads();
}
DI void dispatch_block(unsigned char* ws, int vb, int* lds) {
    const int* hist = (const int*)(ws + WS_HIST); const int* topi = (const int*)(ws + WS_TOPI); const float* topw = (const float*)(ws + WS_TOPW);
    int* tslot = (int*)(ws + WS_TSLOT); int* rtok = (int*)(ws + WS_RTOK); float* rw = (float*)(ws + WS_RW); int* pane = (int*)(ws + WS_PANE);
    int* cnt = lds, *base = lds + 32, *pstart = lds + 64, *npan = lds + 96;
    if (threadIdx.x < 32) { const int e = threadIdx.x; int c = 0, bsum = 0; for (int b2 = 0; b2 < NRB; ++b2) { const int hv = hist[b2 * 32 + e]; c += hv; if (b2 < vb) bsum += hv; } cnt[e] = c; base[e] = bsum; }
    __syncthreads();
    if (threadIdx.x == 0) { int acc = 0; for (int e = 0; e < 32; ++e) { pstart[e] = acc; acc += ((cnt[e] + 255) >> 8) << 8; } npan[0] = acc >> 8; }
    __syncthreads();
    if (threadIdx.x < 32) {
        const int e = threadIdx.x; int slot = pstart[e] + base[e];
        for (int a = 0; a < 256; ++a) { if (topi[vb * 256 + a] == e) { tslot[vb * 256 + a] = slot; rtok[slot] = vb * 64 + (a >> 2); rw[slot] = topw[vb * 256 + a]; ++slot; } }
        if (vb == 0) { const int p0 = pstart[e] >> 8, p1 = p0 + ((cnt[e] + 255) >> 8); for (int p = p0; p < p1; ++p) pane[p] = e; if (e == 0) pane[511] = npan[0]; }
    }
    __syncthreads();
    const bf16_t* x1b = (const bf16_t*)(ws + WS_X1B); bf16_t* xs = (bf16_t*)(ws + WS_XS);
    for (int i = threadIdx.x; i < 256 * 128; i += blockDim.x) {
        const int a = i >> 7, c = i & 127; const int slot = tslot[vb * 256 + a];
        *(u32x4_t*)(xs + (size_t)slot * DM + 8 * c) = *(const u32x4_t*)(x1b + (size_t)(vb * 64 + (a >> 2)) * DM + 8 * c);
    }
    __syncthreads();
}
DI void combine_row(unsigned char* ws, int tok, const float* g, const float* bta, float* outF, bf16_t* outB, int lane) {
    typedef float f4 __attribute__((ext_vector_type(4)));
    const float* x1 = (const float*)(ws + WS_X1F) + (size_t)tok * DM; const bf16_t* ys = (const bf16_t*)(ws + WS_YS); const int* tslot = (const int*)(ws + WS_TSLOT) + tok * 4;
    f4 v[4]; float s = 0.f;
#pragma unroll
    for (int j = 0; j < 4; ++j) v[j] = *(const f4*)(x1 + 256 * j + 4 * lane) * DN_ALPHA;
#pragma unroll
    for (int k = 0; k < 4; ++k) { const bf16_t* yr = ys + (size_t)tslot[k] * DM;
#pragma unroll
        for (int j = 0; j < 4; ++j) { const uint2 pk = *(const uint2*)(yr + 256 * j + 4 * lane);
            v[j].x += __uint_as_float(pk.x << 16); v[j].y += __uint_as_float(pk.x & 0xffff0000u); v[j].z += __uint_as_float(pk.y << 16); v[j].w += __uint_as_float(pk.y & 0xffff0000u); } }
#pragma unroll
    for (int j = 0; j < 4; ++j) s += (v[j].x + v[j].y) + (v[j].z + v[j].w);
    const float mean = wave_sum(s) * (1.f / DM); float s2 = 0.f;
#pragma unroll
    for (int j = 0; j < 4; ++j) { v[j] = v[j] - mean; s2 += (v[j].x * v[j].x + v[j].y * v[j].y) + (v[j].z * v[j].z + v[j].w * v[j].w); }
    const float rstd = rsqrtf(wave_sum(s2) * (1.f / DM) + LN_EPS);
#pragma unroll
    for (int j = 0; j < 4; ++j) {
        const f4 gg = *(const f4*)(g + 256 * j + 4 * lane), bb = *(const f4*)(bta + 256 * j + 4 * lane);
        const f4 o = v[j] * rstd * gg + bb;
        *(f4*)(outF + (size_t)tok * DM + 256 * j + 4 * lane) = o;
        if (outB) { uint2 pk; pk.x = (unsigned)f2bf(o.x) | ((unsigned)f2bf(o.y) << 16); pk.y = (unsigned)f2bf(o.z) | ((unsigned)f2bf(o.w) << 16); *(uint2*)(outB + (size_t)tok * DM + 256 * j + 4 * lane) = pk; }
    }
}

__global__ void __launch_bounds__(256) k_ln1(const float* Y, const float* g, const float* b, float* X1F, bf16_t* X1B) {
    const int row = blockIdx.x * 4 + (threadIdx.x >> 6); ln_row(Y + (size_t)row * DM, g, b, X1F + (size_t)row * DM, X1B + (size_t)row * DM, threadIdx.x & 63);
}
__global__ void __launch_bounds__(256) k_router_naive(const float* X1F, const float* wr, const float* br, float* logits) {
    const int gid = blockIdx.x * 256 + threadIdx.x, tok = gid >> 5, e = gid & 31; const float* x = X1F + (size_t)tok * DM; float acc = 0.f;
    for (int k = 0; k < DM; ++k) acc += x[k] * wr[k * 32 + e];
    logits[gid] = acc + br[e];
}
__global__ void __launch_bounds__(256) k_topk(const float* logits, int* ti, float* tw) { const int tok = blockIdx.x * 256 + threadIdx.x; topk_token(logits + tok * 32, ti + tok * 4, tw + tok * 4); }
__global__ void __launch_bounds__(256) k_hist(unsigned char* ws) { __shared__ int lh[32]; hist_block((const int*)(ws + WS_TOPI), (int*)(ws + WS_HIST), blockIdx.x, lh); }
__global__ void __launch_bounds__(256) k_dispatch(unsigned char* ws) { __shared__ int l[128]; dispatch_block(ws, blockIdx.x, l); }
__global__ void __launch_bounds__(256) k_combine(unsigned char* ws, const float* g, const float* b, float* outF, bf16_t* outB) {
    const int tok = blockIdx.x * 4 + (threadIdx.x >> 6); combine_row(ws, tok, g, b, outF, outB, threadIdx.x & 63);
}

namespace pg8 {
#define PG8_LAS __attribute__((address_space(3)))
typedef unsigned short bf16_t;
typedef short bf16x8 __attribute__((ext_vector_type(8)));
typedef float f32x4 __attribute__((ext_vector_type(4)));
typedef unsigned u32x4 __attribute__((ext_vector_type(4)));
constexpr int BM = 256, BK = 64, HALF = 128, HTB = HALF * BK * 2  , STAGE_BYTES = 8 * HTB, NXCD = 8, WGM = 8;

__host__ __device__ __forceinline__ int lds_byte(int r, int c) { const int st = (r >> 4) * 2 + (c >> 5), rr = r & 15, cc = c & 31, ob = rr * 64 + cc * 2; return st * 1024 + (ob ^ (((ob >> 9) & 1) << 5)); }
__host__ __device__ __forceinline__ void stage_rc(int b, int& R, int& C) { const int st = b / 1024, sb = b % 1024, swz = sb ^ (((sb >> 9) & 1) << 5); R = (st >> 1) * 16 + swz / 64; C = (st & 1) * 32 + (swz % 64) / 2; }
__host__ __device__ __forceinline__ int perm32(int rho) { const int n = rho >> 4, i = rho & 15; return 8 * (i >> 2) + 4 * n + (i & 3); }

struct Unit { int pm, pn; };
struct Gemm { const bf16_t* A; const bf16_t* Bt; int M, N, K; };

struct StaticOrder {
    int nM, nN, nwg, G, c;
    __host__ __device__ void init(int M, int N, int G_, int c_) { nM = M / BM; nN = N / BM; nwg = nM * nN; G = G_; c = c_; }
    __host__ __device__ bool next(int i, Unit& u) const {
        const long L = (long)i * G + c; if (L >= nwg) return false;
        int wgid = (int)L; { const int q = nwg / NXCD, r = nwg % NXCD, xcd = wgid % NXCD, off = wgid / NXCD; wgid = (xcd < r ? xcd * (q + 1) : r * (q + 1) + (xcd - r) * q) + off; }
        const int nig = WGM * nN, gid = wgid / nig, fm = gid * WGM, gsz = (nM - fm) < WGM ? (nM - fm) : WGM;
        u.pm = fm + ((wgid % nig) % gsz); u.pn = (wgid % nig) / gsz; return true;
    }
    __device__ __forceinline__ void a_ready(const Unit&) const {}
    __device__ __forceinline__ void done(const Unit&) const {}
};
__device__ __forceinline__ unsigned cvt_pk_bf16(float lo, float hi) { unsigned r; asm volatile("v_cvt_pk_bf16_f32 %0, %1, %2" : "=v"(r) : "v"(lo), "v"(hi)); return r; }
typedef float f32x2 __attribute__((ext_vector_type(2)));
template <class Epi, class Sched, bool ALIGN_EPI = false, bool SP2 = false>
__device__ __forceinline__ void gemm_phase(PG8_LAS unsigned char* lds, const Gemm g, const Sched& S, const Epi& E) {
    int tid = threadIdx.x; asm volatile("" : "+v"(tid));
    const int wid = __builtin_amdgcn_readfirstlane(tid >> 6), lane = tid & 63, wr = wid >> 2, wc = wid & 3, fr = lane & 15, fq = lane >> 4;
    const int K = g.K, nt = K / BK;
    unsigned voffA[2], voffB[2];
#pragma unroll
    for (int i = 0; i < 2; ++i) { int R, C; stage_rc(tid * 16 + i * 8192, R, C); const int Rb = Epi::PERM ? ((R & ~31) + perm32(R & 31)) : R;
        voffA[i] = (unsigned)(R * K + C) * 2u; voffB[i] = (unsigned)(Rb * K + C) * 2u; }
    const size_t kstep = (size_t)(BK * 2);
    const size_t hstep = (size_t)HALF * K * 2;
    const size_t tstep = 2 * hstep;
    const unsigned ldsw = (unsigned)wid * 1024u;
    const int aoff = lds_byte(wr * 64 + fr, fq * 8), boff = lds_byte(wc * 32 + fr, fq * 8);
#define PG8_SA(b, h) (((b) * 2 + (h)) * HTB)
#define PG8_SB(b, h) ((4 + (b) * 2 + (h)) * HTB)
#define PG8_STAGE(bufoff, gbase, voff) do { _Pragma("unroll") for (int _i = 0; _i < 2; ++_i) \
        __builtin_amdgcn_global_load_lds((const unsigned*)((const char*)(gbase) + (voff)[_i]), (PG8_LAS unsigned*)(lds + (bufoff) + ldsw + _i * 8192), 16, 0, 0); } while (0)
#define PG8_LDA(dst, b, h) do { _Pragma("unroll") for (int m = 0; m < 4; ++m) _Pragma("unroll") for (int k = 0; k < 2; ++k) dst[m][k] = *(const PG8_LAS bf16x8*)(lds + PG8_SA(b, h) + aoff + m * 2048 + k * 1024); } while (0)
#define PG8_LDB(dst, b, h) do { _Pragma("unroll") for (int n = 0; n < 2; ++n) _Pragma("unroll") for (int k = 0; k < 2; ++k) dst[n][k] = *(const PG8_LAS bf16x8*)(lds + PG8_SB(b, h) + boff + n * 2048 + k * 1024); } while (0)
#define PG8_MMA(ai, bj, At, Bt) do { __builtin_amdgcn_s_setprio(1); _Pragma("unroll") for (int m = 0; m < 4; ++m) _Pragma("unroll") for (int n = 0; n < 2; ++n) _Pragma("unroll") for (int k = 0; k < 2; ++k) \
        acc[ai][bj][m][n] = __builtin_amdgcn_mfma_f32_16x16x32_bf16(Bt[n][k], At[m][k], acc[ai][bj][m][n], 0, 0, 0); __builtin_amdgcn_s_setprio(0); } while (0)
#define PG8_WAIT_V(n) asm volatile("s_waitcnt vmcnt(" #n ")" ::: "memory")
#define PG8_WAIT_L(n) asm volatile("s_waitcnt lgkmcnt(" #n ")" ::: "memory")
#define PG8_BAR __builtin_amdgcn_s_barrier()
#define PG8_SCHED __builtin_amdgcn_sched_barrier(0)
    Unit cur, nxt; int ui = 0;
    if (!S.next(0, cur)) return;
    f32x4 acc[2][2][4][2];
#pragma unroll
    for (int a = 0; a < 2; ++a)
#pragma unroll
        for (int b = 0; b < 2; ++b)
#pragma unroll
            for (int m = 0; m < 4; ++m)
#pragma unroll
                for (int n = 0; n < 2; ++n) acc[a][b][m][n] = (f32x4){0.f, 0.f, 0.f, 0.f};
    bf16x8 At[4][2], B0[2][2], B1[2][2];
    const char* cA = (const char*)g.A + (size_t)cur.pm * tstep; const char* cB = (const char*)g.Bt + (size_t)cur.pn * tstep;
    S.a_ready(cur);
    if constexpr (SP2) {
        PG8_STAGE(PG8_SB(0, 0), cB, voffB); PG8_STAGE(PG8_SB(0, 1), cB + hstep, voffB); PG8_STAGE(PG8_SA(0, 0), cA, voffA); PG8_STAGE(PG8_SA(0, 1), cA + hstep, voffA);
        if (wr == 1) PG8_BAR;
        PG8_WAIT_V(2); PG8_BAR;
        PG8_STAGE(PG8_SB(1, 0), cB + kstep, voffB); PG8_STAGE(PG8_SA(1, 0), cA + kstep, voffA); PG8_STAGE(PG8_SB(1, 1), cB + hstep + kstep, voffB);
        PG8_WAIT_V(6); PG8_BAR;
    } else {
        PG8_STAGE(PG8_SB(0, 0), cB, voffB); PG8_STAGE(PG8_SA(0, 0), cA, voffA); PG8_STAGE(PG8_SB(0, 1), cB + hstep, voffB); PG8_STAGE(PG8_SA(0, 1), cA + hstep, voffA);
        if (wr == 1) PG8_BAR;
        PG8_WAIT_V(4); PG8_BAR;
        PG8_STAGE(PG8_SB(1, 0), cB + kstep, voffB); PG8_STAGE(PG8_SA(1, 0), cA + kstep, voffA); PG8_STAGE(PG8_SB(1, 1), cB + hstep + kstep, voffB);
        PG8_WAIT_V(6); PG8_BAR;
    }
    for (;;) {
        const bool has_next = S.next(ui + 1, nxt);
        const char* nA = has_next ? (const char*)g.A + (size_t)nxt.pm * tstep : cA; const char* nB = has_next ? (const char*)g.Bt + (size_t)nxt.pn * tstep : cB;
        for (int t = 0; t < nt; t += 2) {
            const bool last = (t == nt - 2);
            const char* a1 = cA + (size_t)(t + 1) * kstep;
            const char* a2 = last ? nA : cA + (size_t)(t + 2) * kstep; const char* b2 = last ? nB : cB + (size_t)(t + 2) * kstep;
            const char* a3 = a2 + kstep; const char* b3 = b2 + kstep;
            if (last && has_next) S.a_ready(nxt);
            if constexpr (SP2) {
            PG8_LDB(B0, 0, 0); PG8_LDB(B1, 0, 1); PG8_SCHED; PG8_LDA(At, 0, 0); PG8_STAGE(PG8_SA(1, 1), a1 + hstep, voffA);
            PG8_WAIT_V(8); PG8_WAIT_L(0); PG8_BAR; PG8_MMA(0, 0, At, B0); PG8_MMA(0, 1, At, B1); PG8_BAR; PG8_SCHED;
            PG8_LDA(At, 0, 1); PG8_STAGE(PG8_SB(0, 0), b2, voffB); PG8_STAGE(PG8_SB(0, 1), b2 + hstep, voffB); PG8_STAGE(PG8_SA(0, 0), a2, voffA);
            PG8_WAIT_V(8); PG8_WAIT_L(0); PG8_BAR; PG8_MMA(1, 0, At, B0); PG8_MMA(1, 1, At, B1); PG8_BAR; PG8_SCHED;
            PG8_LDB(B0, 1, 0); PG8_LDB(B1, 1, 1); PG8_SCHED; PG8_LDA(At, 1, 0); PG8_STAGE(PG8_SA(0, 1), a2 + hstep, voffA);
            PG8_WAIT_V(8); PG8_WAIT_L(0); PG8_BAR; PG8_MMA(0, 0, At, B0); PG8_MMA(0, 1, At, B1); PG8_BAR; PG8_SCHED;
            PG8_LDA(At, 1, 1); PG8_STAGE(PG8_SB(1, 0), b3, voffB); PG8_STAGE(PG8_SB(1, 1), b3 + hstep, voffB); PG8_STAGE(PG8_SA(1, 0), a3, voffA);
            PG8_WAIT_V(8); PG8_WAIT_L(0); PG8_BAR; PG8_MMA(1, 0, At, B0); PG8_MMA(1, 1, At, B1); PG8_BAR; PG8_SCHED;
            } else {
            PG8_LDB(B0, 0, 0); PG8_SCHED; PG8_LDA(At, 0, 0); PG8_STAGE(PG8_SA(1, 1), a1 + hstep, voffA);
            PG8_WAIT_L(8); PG8_BAR; PG8_WAIT_L(0); PG8_MMA(0, 0, At, B0); PG8_BAR; PG8_SCHED;
            PG8_LDB(B1, 0, 1); PG8_STAGE(PG8_SB(0, 0), b2, voffB);
            PG8_BAR; PG8_WAIT_L(0); PG8_MMA(0, 1, At, B1); PG8_BAR;
            PG8_LDA(At, 0, 1); PG8_STAGE(PG8_SA(0, 0), a2, voffA);
            PG8_BAR; PG8_WAIT_L(0); PG8_MMA(1, 0, At, B0); PG8_BAR; PG8_SCHED;
            PG8_STAGE(PG8_SB(0, 1), b2 + hstep, voffB);
            PG8_WAIT_V(6); PG8_BAR; PG8_MMA(1, 1, At, B1); PG8_BAR;
            PG8_LDB(B0, 1, 0); PG8_SCHED; PG8_LDA(At, 1, 0); PG8_STAGE(PG8_SA(0, 1), a2 + hstep, voffA);
            PG8_WAIT_L(8); PG8_BAR; PG8_WAIT_L(0); PG8_MMA(0, 0, At, B0); PG8_BAR; PG8_SCHED;
            PG8_LDB(B1, 1, 1); PG8_STAGE(PG8_SB(1, 0), b3, voffB);
            PG8_BAR; PG8_WAIT_L(0); PG8_MMA(0, 1, At, B1); PG8_BAR;
            PG8_LDA(At, 1, 1); PG8_STAGE(PG8_SA(1, 0), a3, voffA);
            PG8_BAR; PG8_WAIT_L(0); PG8_MMA(1, 0, At, B0); PG8_BAR; PG8_SCHED;
            PG8_STAGE(PG8_SB(1, 1), b3 + hstep, voffB);
            PG8_WAIT_V(6); PG8_BAR; PG8_MMA(1, 1, At, B1); PG8_BAR;
            }
        }
        if constexpr (ALIGN_EPI) { if (wr == 0) PG8_BAR; }
        if constexpr (!Epi::AFTER_DRAIN) { E(acc, cur, wr, wc, fr, fq); S.done(cur); }
        if (!has_next) break;
#pragma unroll
        for (int a = 0; a < 2; ++a)
#pragma unroll
            for (int b = 0; b < 2; ++b)
#pragma unroll
                for (int m = 0; m < 4; ++m)
#pragma unroll
                    for (int n = 0; n < 2; ++n) acc[a][b][m][n] = (f32x4){0.f, 0.f, 0.f, 0.f};
        cur = nxt; cA = nA; cB = nB; ++ui;
        if constexpr (ALIGN_EPI) { if (wr == 1) PG8_BAR; }
    }
    PG8_WAIT_V(0);
    if constexpr (!ALIGN_EPI) { if (wr == 0) PG8_BAR; }
    PG8_BAR;
    if constexpr (Epi::AFTER_DRAIN) { E.fused(acc, cur, wr, wc, fr, fq, lds, wid, lane); S.done(cur); }
#undef PG8_SA
#undef PG8_SB
#undef PG8_STAGE
#undef PG8_LDA
#undef PG8_LDB
#undef PG8_MMA
#undef PG8_WAIT_V
#undef PG8_WAIT_L
#undef PG8_BAR
#undef PG8_SCHED
}
}

#define GAS __attribute__((address_space(1)))
#define LAS __attribute__((address_space(3)))
typedef GAS unsigned gu32;
typedef GAS unsigned long long gu64;
#define RLX_AGENT __ATOMIC_RELAXED, __HIP_MEMORY_SCOPE_AGENT
#define XB_TMO      128
#define XB_XCNT(j)  (256  + 64 * (j))
#define XB_XSUB(j)  (1280 + 64 * (j))
#define XB_XGEN(j)  (2304 + 64 * (j))
#define XB_TOP      3328
#define XB_TOPGEN   3392
#define XCD_BAR_WORDS 3456
#define XB_SPIN_CAP (1u << 18)

__device__ __forceinline__ unsigned xb_ld(unsigned* p)              { return __hip_atomic_load(p, __ATOMIC_RELAXED, __HIP_MEMORY_SCOPE_AGENT); }
__device__ __forceinline__ unsigned xb_add(unsigned* p, unsigned v) { return __hip_atomic_fetch_add(p, v, __ATOMIC_RELAXED, __HIP_MEMORY_SCOPE_AGENT); }
__device__ __forceinline__ unsigned xb_xcc_id() { return (unsigned)__builtin_amdgcn_s_getreg((3 << 11) | 20) & 0xFu; }
#define XB_SPIN(cond, bar) do { unsigned _sp = 0; while (cond) { __builtin_amdgcn_s_sleep(1); \
    if ((++_sp & 255u) == 0u) { if (xb_ld(&(bar)[XB_TMO])) break; if (_sp > XB_SPIN_CAP) { atomicAdd(&(bar)[XB_TMO], 1u); break; } } } } while (0)

struct XcdBarrier {
    unsigned* bar; unsigned x;
    volatile LAS unsigned* st;
};

__device__ __forceinline__ XcdBarrier xcd_barrier_post(unsigned* bar, volatile LAS unsigned* st) {
    XcdBarrier b; b.bar = bar; b.x = xb_xcc_id(); b.st = st;
    if (threadIdx.x == 0) (void)xb_add(&bar[XB_XCNT(b.x)], 1u);
    return b;
}
__device__ __forceinline__ void xcd_barrier_complete(unsigned* bar, unsigned x, unsigned& nloc, unsigned& nx) {
    const unsigned G = gridDim.x * gridDim.y * gridDim.z;
    unsigned sum, cnt, mine, sp = 0u;
    for (;;) {
        sum = 0u; cnt = 0u; mine = 0u;
#pragma unroll
        for (unsigned j = 0; j < 16; ++j) { const unsigned c = xb_ld(&bar[XB_XCNT(j)]); sum += c; cnt += (c > 0u) ? 1u : 0u; mine = (j == x) ? c : mine; }
        if (sum == G) break;
        __builtin_amdgcn_s_sleep(1);
        if ((++sp & 255u) == 0u) { if (xb_ld(&bar[XB_TMO])) break; if (sp > XB_SPIN_CAP) { atomicAdd(&bar[XB_TMO], 1u); break; } }
    }
    nloc = mine > 0u ? mine : 1u; nx = cnt > 0u ? cnt : 1u;
}

__device__ __forceinline__ void xcd_barrier(const XcdBarrier& b) {
    asm volatile("s_waitcnt vmcnt(0)" ::: "memory");
    __syncthreads();
    if (threadIdx.x == 0) {
        unsigned* bar = b.bar;
        __builtin_amdgcn_s_waitcnt(0);
        unsigned nloc = b.st[0], nx = b.st[1];
        if (nloc == 0u) { xcd_barrier_complete(bar, b.x, nloc, nx); b.st[0] = nloc; b.st[1] = nx; }
        const unsigned old = xb_add(&bar[XB_XSUB(b.x)], 1u);
        const unsigned gen = old / nloc;
        if (old + 1u == (gen + 1u) * nloc) {
            __builtin_amdgcn_fence(__ATOMIC_RELEASE, "agent");
            asm volatile("s_waitcnt vmcnt(0)" ::: "memory");
            const unsigned og = xb_add(&bar[XB_TOP], 1u);
            const unsigned tg = og / nx;
            if (og + 1u == (tg + 1u) * nx) xb_add(&bar[XB_TOPGEN], 1u);
            else XB_SPIN(xb_ld(&bar[XB_TOPGEN]) == tg, bar);
            __builtin_amdgcn_fence(__ATOMIC_ACQUIRE, "agent");
            xb_add(&bar[XB_XGEN(b.x)], 1u);
            asm volatile("s_waitcnt vmcnt(0)" ::: "memory");
        } else {
            XB_SPIN(xb_ld(&bar[XB_XGEN(b.x)]) == gen, bar);
            __builtin_amdgcn_fence(__ATOMIC_ACQUIRE, "agent");
            asm volatile("s_waitcnt vmcnt(0)" ::: "memory");
        }
    }
    __syncthreads();
}

typedef short bf16x8 __attribute__((ext_vector_type(8)));
typedef float f32x16 __attribute__((ext_vector_type(16)));
typedef float f32x4 __attribute__((ext_vector_type(4)));
#define MFMA32(a, b, c) __builtin_amdgcn_mfma_f32_32x32x16_bf16((a), (b), (c), 0, 0, 0)

constexpr int NWAVES = 8, NTHREADS = 512;
constexpr int LDS_GEMM = 131072;
constexpr int LDS_MISC = LDS_GEMM;
constexpr int LDS_BYTES = 147456;
constexpr int CW_BAR = 4096;
constexpr int NPHASE = 19;

struct MArgs { const float* in[21]; float* out; unsigned char* ws; int ph_lo, ph_hi; };

DI unsigned pk2bf(float lo, float hi) { return pg8::cvt_pk_bf16(lo, hi); }
DI float fast_sigmoid(float x) { return __builtin_amdgcn_rcpf(1.f + __builtin_amdgcn_exp2f(-LOG2E * x)); }

constexpr int TP_PITCH = 72;
DI void transpose_item(const float* W, int K, int N, int k0, int n0, bf16_t* dst  , LAS bf16_t* T, int lane) {
    const int kr = lane >> 4, nc = lane & 15;
#pragma unroll 4
    for (int it = 0; it < 16; ++it) {
        const f32x4 v = *(const f32x4*)(W + (size_t)(k0 + 4 * it + kr) * N + n0 + 4 * nc);
        const int k = 4 * it + kr;
        T[(4 * nc + 0) * TP_PITCH + k] = f2bf(v.x); T[(4 * nc + 1) * TP_PITCH + k] = f2bf(v.y); T[(4 * nc + 2) * TP_PITCH + k] = f2bf(v.z); T[(4 * nc + 3) * TP_PITCH + k] = f2bf(v.w);
    }
    asm volatile("s_waitcnt lgkmcnt(0)" ::: "memory");
    const int nr = lane >> 3, kc = lane & 7;
#pragma unroll
    for (int it = 0; it < 8; ++it) {
        const int n = 8 * it + nr;
        const u32x4_t o = *(const LAS u32x4_t*)(T + n * TP_PITCH + 8 * kc);
        *(u32x4_t*)(dst + (size_t)n * K + k0 + 8 * kc) = o;
    }
    asm volatile("s_waitcnt lgkmcnt(0)" ::: "memory");
}
DI int win_row(int n0) {
    if (n0 < 512) return n0;
    if (n0 < 640) return 5632 + (n0 - 512);
    if (n0 < 768) return 5888 + (n0 - 640);
    if (n0 < 1280) return 512 + (n0 - 768);
    if (n0 < 1792) return 1024 + (n0 - 1280);
    if (n0 < 2304) return 5888 + 128 + (n0 - 1792);
    if (n0 < 2816) return 1536 + (n0 - 2304);
    if (n0 < 3328) return 2048 + (n0 - 2816);
    if (n0 < 3840) return 5888 + 640 + (n0 - 3328);
    return 2560 + (n0 - 3840);
}
DI void prologue_phase(const MArgs& A, LAS unsigned char* lds, int gw, int ngw, int wave, int lane) {
    LAS bf16_t* T = (LAS bf16_t*)(lds + wave * 16384);
    constexpr int I_IN = 16 * 108, I_OUT = 16 * 16, I_BR = 3 * 8 * 16, I_UP = 32 * 16 * 32, I_DN = 32 * 16 * 16, I_L = I_IN + I_OUT + I_BR + I_UP + I_DN;
    for (int it = gw; it < 2 * I_L; it += ngw) {
        const int l = it / I_L; int r = it % I_L;
        unsigned char* wl = A.ws + WS_W + (size_t)l * WL_BYTES;
        if (r < I_IN) { const int kb = r / 108, nb = r % 108; const float* W = A.in[1] + (size_t)l * DM * IN_W;
            transpose_item(W, DM, IN_W, 64 * kb, 64 * nb, (bf16_t*)(wl + WL_IN) + (size_t)win_row(64 * nb) * DM, T, lane); continue; }
        r -= I_IN;
        if (r < I_OUT) { const int kb = r / 16, nb = r % 16; const float* W = A.in[10] + (size_t)l * DM * DM;
            transpose_item(W, DM, DM, 64 * kb, 64 * nb, (bf16_t*)(wl + WL_OUT) + (size_t)(64 * nb) * DM, T, lane); continue; }
        r -= I_OUT;
        if (r < I_BR) { const int i = r / 128, q = r % 128, kb = q / 16, nb = q % 16; const float* W = A.in[9] + ((size_t)l * 3 + i) * 512 * DM;
            transpose_item(W, 512, DM, 64 * kb, 64 * nb, (bf16_t*)(wl + WL_BR) + (size_t)(i * 1024 + 64 * nb) * 512, T, lane); continue; }
        r -= I_BR;
        if (r < I_UP) { const int e = r / 512, q = r % 512, kb = q / 32, nb = q % 32; const float* W = A.in[15] + ((size_t)l * NE + e) * DM * 2048;
            const int n0 = 64 * nb, nn = n0 & 1023, row = (nn >> 7) * 256 + (n0 >= 1024 ? 128 : 0) + (nn & 127);
            transpose_item(W, DM, 2048, 64 * kb, n0, (bf16_t*)(wl + WL_UP) + (size_t)(e * 2048 + row) * DM, T, lane); continue; }
        r -= I_UP;
        { const int e = r / 256, q = r % 256, kb = q / 16, nb = q % 16; const float* W = A.in[17] + ((size_t)l * NE + e) * FE * DM;
            transpose_item(W, FE, DM, 64 * kb, 64 * nb, (bf16_t*)(wl + WL_DN) + (size_t)(e * 1024 + 64 * nb) * FE, T, lane); }
    }
    for (int m = gw; m < NTOK; m += ngw) {
        const float* xr = A.in[0] + (size_t)m * DM; bf16_t* o = (bf16_t*)(A.ws + WS_XB) + (size_t)m * DM;
#pragma unroll
        for (int j = 0; j < 4; ++j) { const f32x4 v = *(const f32x4*)(xr + 256 * j + 4 * lane); uint2 pk; pk.x = pk2bf(v.x, v.y); pk.y = pk2bf(v.z, v.w); *(uint2*)(o + 256 * j + 4 * lane) = pk; }
    }
}

struct SchedInProj {
    pg8::StaticOrder so; int xb0, w0;
    DI bool next(int i, pg8::Unit& u) const { pg8::Unit v; if (!so.next(i, v)) return false;
        if (v.pn < 23) { u.pm = xb0 + v.pm; u.pn = w0 + v.pn; } else { u.pm = w0 + v.pn; u.pn = xb0 + v.pm; } return true; }
    DI void a_ready(const pg8::Unit&) const {}
    DI void done(const pg8::Unit&) const {}
};
struct SchedBranch {
    int c, G, a0, b0;
    DI bool next(int i, pg8::Unit& u) const { const int p = c + (i / 3) * G; if (p >= 256) return false; const int br = i % 3; u.pm = a0 + br * 64 + (p >> 2); u.pn = b0 + br * 4 + (p & 3); return true; }
    DI void a_ready(const pg8::Unit&) const {}
    DI void done(const pg8::Unit&) const {}
};
struct SchedPlain {
    pg8::StaticOrder so; int a0, b0;
    DI bool next(int i, pg8::Unit& u) const { pg8::Unit v; if (!so.next(i, v)) return false; u.pm = a0 + v.pm; u.pn = b0 + v.pn; return true; }
    DI void a_ready(const pg8::Unit&) const {}
    DI void done(const pg8::Unit&) const {}
};
struct SchedMoe {
    const int* pane; int NJ, a0, b0, G, c, nunits;
    DI bool next(int i, pg8::Unit& u) const {
        const long L = (long)i * G + c; if (L >= nunits) return false;
        int id = (int)L; { const int q = nunits / 8, r = nunits % 8, x = id % 8, off = id / 8; id = (x < r ? x * (q + 1) : r * (q + 1) + (x - r) * q) + off; }
        const int p = id / NJ, j = id % NJ; const int e = __builtin_amdgcn_readfirstlane(pane[p]);
        u.pm = a0 + p; u.pn = b0 + e * NJ + j; return true; }
    DI void a_ready(const pg8::Unit&) const {}
    DI void done(const pg8::Unit&) const {}
};

struct EpiInProj {
    static constexpr bool PERM = true, AFTER_DRAIN = false;
    unsigned char* ws; int xb0, w0;
    DI void operator()(const f32x4 (&acc)[2][2][4][2], const pg8::Unit& u, int wr, int wc, int fr, int fq) const {
        const int r0 = wr * 64 + fr, c0 = wc * 32 + 8 * fq;
        if (u.pm >= xb0) {
            const int t = u.pn - w0, tok0 = (u.pm - xb0) * 256;
            bf16_t* base; int ld, colb; float sc = 1.f; bool sig = false; int nbj = 2;
            if (t < 2) { base = (bf16_t*)(ws + WS_QA); ld = 512; colb = 256 * t; sc = C2; }
            else if (t < 4) { base = (bf16_t*)(ws + WS_QB); ld = 512; colb = 256 * (t - 2); sc = C2; }
            else if (t < 6) { base = (bf16_t*)(ws + WS_KB); ld = 512; colb = 256 * (t - 4); }
            else if (t < 8) { base = (bf16_t*)(ws + WS_QC); ld = 512; colb = 256 * (t - 6); sc = C2; }
            else if (t < 10) { base = (bf16_t*)(ws + WS_KC); ld = 512; colb = 256 * (t - 8); }
            else if (t < 22) { base = (bf16_t*)(ws + WS_G); ld = 3072; colb = 256 * (t - 10); sig = true; }
            else { base = (bf16_t*)(ws + WS_KA); ld = 128; colb = 0; nbj = 1; }
#pragma unroll
            for (int ai = 0; ai < 2; ++ai)
#pragma unroll
                for (int m = 0; m < 4; ++m) { bf16_t* rowp = base + (size_t)(tok0 + r0 + ai * 128 + m * 16) * ld + colb + c0;
#pragma unroll
                    for (int bj = 0; bj < 2; ++bj) { if (bj < nbj) { f32x4 v0 = acc[ai][bj][m][0] * sc, v1 = acc[ai][bj][m][1] * sc;
                        if (sig) { v0 = (f32x4){fast_sigmoid(v0.x), fast_sigmoid(v0.y), fast_sigmoid(v0.z), fast_sigmoid(v0.w)}; v1 = (f32x4){fast_sigmoid(v1.x), fast_sigmoid(v1.y), fast_sigmoid(v1.z), fast_sigmoid(v1.w)}; }
                        u32x4_t w; w.x = pk2bf(v0.x, v0.y); w.y = pk2bf(v0.z, v0.w); w.z = pk2bf(v1.x, v1.y); w.w = pk2bf(v1.z, v1.w);
                        *(u32x4_t*)(rowp + bj * 128) = w; } } }
        } else {
            const int ch0 = (u.pm - w0 - 23) * 256, tok0 = (u.pn - xb0) * 256; bf16_t* VT = (bf16_t*)(ws + WS_VT);
#pragma unroll
            for (int ai = 0; ai < 2; ++ai)
#pragma unroll
                for (int m = 0; m < 4; ++m) { bf16_t* rowp = VT + (size_t)(ch0 + r0 + ai * 128 + m * 16) * NTOK + tok0 + c0;
#pragma unroll
                    for (int bj = 0; bj < 2; ++bj) { const f32x4 v0 = acc[ai][bj][m][0], v1 = acc[ai][bj][m][1];
                        u32x4_t w; w.x = pk2bf(v0.x, v0.y); w.y = pk2bf(v0.z, v0.w); w.z = pk2bf(v1.x, v1.y); w.w = pk2bf(v1.z, v1.w);
                        *(u32x4_t*)(rowp + bj * 128) = w; } }
        }
    }
};
struct EpiBranch {
    static constexpr bool PERM = true, AFTER_DRAIN = false;
    unsigned char* ws; int a0, b0;
    DI void operator()(const f32x4 (&acc)[2][2][4][2], const pg8::Unit& u, int wr, int wc, int fr, int fq) const {
        const int i = (u.pn - b0) >> 2, pn = (u.pn - b0) & 3, pm = (u.pm - a0) & 63;
        const bf16_t* G = (const bf16_t*)(ws + WS_G); float* MF = (float*)(ws + WS_MF); bf16_t* MB = (bf16_t*)(ws + WS_MB);
        const int r0 = pm * 256 + wr * 64 + fr, c0 = pn * 256 + wc * 32 + 8 * fq;
#pragma unroll
        for (int ai = 0; ai < 2; ++ai)
#pragma unroll
            for (int m = 0; m < 4; ++m) { const size_t row = (size_t)(r0 + ai * 128 + m * 16);
#pragma unroll
                for (int bj = 0; bj < 2; ++bj) { const int col = c0 + bj * 128;
                    const u32x4_t gw = *(const u32x4_t*)(G + row * 3072 + i * 1024 + col);
                    f32x4 v0, v1;
                    v0.x = __uint_as_float(gw.x << 16) * acc[ai][bj][m][0].x; v0.y = __uint_as_float(gw.x & 0xffff0000u) * acc[ai][bj][m][0].y;
                    v0.z = __uint_as_float(gw.y << 16) * acc[ai][bj][m][0].z; v0.w = __uint_as_float(gw.y & 0xffff0000u) * acc[ai][bj][m][0].w;
                    v1.x = __uint_as_float(gw.z << 16) * acc[ai][bj][m][1].x; v1.y = __uint_as_float(gw.z & 0xffff0000u) * acc[ai][bj][m][1].y;
                    v1.z = __uint_as_float(gw.w << 16) * acc[ai][bj][m][1].z; v1.w = __uint_as_float(gw.w & 0xffff0000u) * acc[ai][bj][m][1].w;
                    float* mp = MF + row * DM + col;
                    if (i > 0) { v0 += *(const f32x4*)mp; v1 += *(const f32x4*)(mp + 4); }
                    if (i < 2) { *(f32x4*)mp = v0; *(f32x4*)(mp + 4) = v1; }
                    else { u32x4_t w; w.x = pk2bf(v0.x, v0.y); w.y = pk2bf(v0.z, v0.w); w.z = pk2bf(v1.x, v1.y); w.w = pk2bf(v1.z, v1.w); *(u32x4_t*)(MB + row * DM + col) = w; } } }
    }
};
struct EpiWout {
    static constexpr bool PERM = false, AFTER_DRAIN = false;
    const float* x; float* Y; int a0, b0;
    DI void operator()(const f32x4 (&acc)[2][2][4][2], const pg8::Unit& u, int wr, int wc, int fr, int fq) const {
        const int r0 = (u.pm - a0) * 256 + wr * 64 + fr, c0 = (u.pn - b0) * 256 + wc * 32 + 4 * fq;
#pragma unroll
        for (int ai = 0; ai < 2; ++ai)
#pragma unroll
            for (int m = 0; m < 4; ++m) { const size_t ro = (size_t)(r0 + ai * 128 + m * 16) * DM + c0;
#pragma unroll
                for (int bj = 0; bj < 2; ++bj)
#pragma unroll
                    for (int n = 0; n < 2; ++n) { const size_t o = ro + bj * 128 + n * 16; *(f32x4*)(Y + o) = *(const f32x4*)(x + o) * DN_ALPHA + acc[ai][bj][m][n]; } }
    }
};
struct EpiUp {
    static constexpr bool PERM = true, AFTER_DRAIN = false;
    unsigned char* ws; const float* b_up; int a0, b0;
    DI void operator()(const f32x4 (&acc)[2][2][4][2], const pg8::Unit& u, int wr, int wc, int fr, int fq) const {
        const int t = u.pn - b0, e = t >> 3, j = t & 7; bf16_t* ACT = (bf16_t*)(ws + WS_ACTB);
        const int r0 = (u.pm - a0) * 256 + wr * 64 + fr, c0 = j * 128 + wc * 32 + 8 * fq;
        f32x4 bg[2], bl[2];
#pragma unroll
        for (int n = 0; n < 2; ++n) { bg[n] = *(const f32x4*)(b_up + e * 2048 + c0 + 4 * n); bl[n] = *(const f32x4*)(b_up + e * 2048 + 1024 + c0 + 4 * n) + 1.f; }
#pragma unroll
        for (int ai = 0; ai < 2; ++ai)
#pragma unroll
            for (int m = 0; m < 4; ++m) { float o[8];
#pragma unroll
                for (int n = 0; n < 2; ++n)
#pragma unroll
                    for (int q = 0; q < 4; ++q) { float hg = acc[ai][0][m][n][q] + bg[n][q], hl = acc[ai][1][m][n][q] + bl[n][q];
                        hg = fminf(hg, SWI_LIMIT); hl = fminf(fmaxf(hl, 1.f - SWI_LIMIT), 1.f + SWI_LIMIT);
                        o[4 * n + q] = hg * fast_sigmoid(SWI_ALPHA * hg) * hl; }
                u32x4_t w; w.x = pk2bf(o[0], o[1]); w.y = pk2bf(o[2], o[3]); w.z = pk2bf(o[4], o[5]); w.w = pk2bf(o[6], o[7]);
                *(u32x4_t*)(ACT + (size_t)(r0 + ai * 128 + m * 16) * FE + c0) = w; }
    }
};
struct EpiDown {
    static constexpr bool PERM = true, AFTER_DRAIN = false;
    unsigned char* ws; const float* b_dn; int a0, b0;
    DI void operator()(const f32x4 (&acc)[2][2][4][2], const pg8::Unit& u, int wr, int wc, int fr, int fq) const {
        const int t = u.pn - b0, e = t >> 2, j = t & 3; bf16_t* YS = (bf16_t*)(ws + WS_YS); const float* rw = (const float*)(ws + WS_RW);
        const int r0 = (u.pm - a0) * 256 + wr * 64 + fr, c0 = j * 256 + wc * 32 + 8 * fq;
        f32x4 bv[2][2];
#pragma unroll
        for (int bj = 0; bj < 2; ++bj)
#pragma unroll
            for (int n = 0; n < 2; ++n) bv[bj][n] = *(const f32x4*)(b_dn + e * DM + c0 + bj * 128 + 4 * n);
#pragma unroll
        for (int ai = 0; ai < 2; ++ai)
#pragma unroll
            for (int m = 0; m < 4; ++m) { const int row = r0 + ai * 128 + m * 16; const float w8 = rw[row];
#pragma unroll
                for (int bj = 0; bj < 2; ++bj) { const f32x4 v0 = (acc[ai][bj][m][0] + bv[bj][0]) * w8, v1 = (acc[ai][bj][m][1] + bv[bj][1]) * w8;
                    u32x4_t w; w.x = pk2bf(v0.x, v0.y); w.y = pk2bf(v0.z, v0.w); w.z = pk2bf(v1.x, v1.y); w.w = pk2bf(v1.z, v1.w);
                    *(u32x4_t*)(YS + (size_t)row * DM + c0 + bj * 128) = w; } }
    }
};

DI int kperm(int r) { return (r & 16) + 8 * ((r >> 2) & 1) + 4 * ((r >> 3) & 1) + (r & 3); }
constexpr float ATT_THR = 8.f;
struct SoftState { float m, l; };
DI bf16x8 pack8(const f32x16& s, int st) {
    u32x4_t p; p.x = pk2bf(s[8 * st + 0], s[8 * st + 1]); p.y = pk2bf(s[8 * st + 2], s[8 * st + 3]); p.z = pk2bf(s[8 * st + 4], s[8 * st + 5]); p.w = pk2bf(s[8 * st + 6], s[8 * st + 7]);
    return __builtin_bit_cast(bf16x8, p);
}
DI f32x16 qk_tile(const bf16_t* krow  , const bf16x8 (&qf)[4]) {
    f32x16 s = {0.f, 0.f, 0.f, 0.f, 0.f, 0.f, 0.f, 0.f, 0.f, 0.f, 0.f, 0.f, 0.f, 0.f, 0.f, 0.f};
#pragma unroll
    for (int st = 0; st < 4; ++st) { const bf16x8 kf = *(const bf16x8*)(krow + 16 * st); s = MFMA32(kf, qf[st], s); }
    return s;
}
template <int NB> DI void soft_tile(f32x16& s, SoftState& st, f32x16 (&o)[NB]) {
    float mx = s[0];
#pragma unroll
    for (int r = 1; r < 16; ++r) mx = fmaxf(mx, s[r]);
    mx = fmaxf(mx, __shfl_xor(mx, 32));
    if (__any(mx > st.m + ATT_THR)) {
        const float mn = fmaxf(st.m, mx), f = __builtin_amdgcn_exp2f(st.m - mn);
        st.m = mn; st.l *= f;
#pragma unroll
        for (int b = 0; b < NB; ++b)
#pragma unroll
            for (int r = 0; r < 16; ++r) o[b][r] *= f;
    }
    float sum = 0.f;
#pragma unroll
    for (int r = 0; r < 16; ++r) { s[r] = __builtin_amdgcn_exp2f(s[r] - st.m); sum += s[r]; }
    st.l += sum;
}
DI void load_qf(bf16x8 (&qf)[4], const bf16_t* qrow  ) {
#pragma unroll
    for (int st = 0; st < 4; ++st) qf[st] = *(const bf16x8*)(qrow + 16 * st);
}
template <int NB> DI void zero_o(f32x16 (&o)[NB]) {
#pragma unroll
    for (int b = 0; b < NB; ++b)
#pragma unroll
        for (int r = 0; r < 16; ++r) o[b][r] = 0.f;
}
template <int NB> DI void pv_tile(f32x16 (&o)[NB], const bf16_t* vt, const bf16x8& p0, const bf16x8& p1) {
#pragma unroll
    for (int b = 0; b < NB; ++b) {
        const bf16x8 v0 = *(const bf16x8*)(vt + (size_t)(32 * b) * NTOK), v1 = *(const bf16x8*)(vt + (size_t)(32 * b) * NTOK + 16);
        o[b] = MFMA32(v0, p0, o[b]); o[b] = MFMA32(v1, p1, o[b]);
    }
}
template <int NB> DI void store_o(const f32x16 (&o)[NB], bf16_t* orow  , int h) {
#pragma unroll
    for (int b = 0; b < NB; ++b)
#pragma unroll
        for (int g = 0; g < 4; ++g) { uint2 pk; pk.x = pk2bf(o[b][4 * g], o[b][4 * g + 1]); pk.y = pk2bf(o[b][4 * g + 2], o[b][4 * g + 3]); *(uint2*)(orow + 32 * b + 8 * g + 4 * h) = pk; }
}

DI void attn_a_task(const MArgs& A, int l, int task, int lane) {
    asm volatile("" : "+v"(lane));
    const int r = lane & 31, h = lane >> 5; const int qt = task & 63, hd = (task >> 6) & 7, b = task >> 9, g = hd >> 2;
    const int q0 = qt * 32, qpos = q0 + r; const size_t tb = (size_t)b * SEQ;
    const bf16_t* QA = (const bf16_t*)(A.ws + WS_QA); const bf16_t* KA = (const bf16_t*)(A.ws + WS_KA); const bf16_t* VT = (const bf16_t*)(A.ws + WS_VT);
    bf16x8 qf[4]; load_qf(qf, QA + (tb + qpos) * 512 + hd * 64 + 8 * h);
    const float slope = exp2f(-8.f * (float)(hd + 1) / 12.f) * LOG2E, sk = A.in[2][l * 8 + hd] * LOG2E;
    f32x16 o[2]; zero_o<2>(o); SoftState st{-1e30f, 0.f};
    const int kp = kperm(r);
    for (int t = 0; t < 9; ++t) {
        const int k0 = q0 - 128 + 32 * t; if (k0 < 0 || k0 >= SEQ) continue;
        f32x16 s = qk_tile(KA + (tb + k0 + kp) * 128 + g * 64 + 8 * h, qf);
#pragma unroll
        for (int reg = 0; reg < 16; ++reg) { const int kpos = k0 + 16 * (reg >> 3) + 8 * h + (reg & 7); const int d = kpos - qpos; const int ad = d < 0 ? -d : d;
            s[reg] = ad <= 128 ? s[reg] - slope * (float)ad : -INFINITY; }
        soft_tile<2>(s, st, o);
        pv_tile<2>(o, VT + (size_t)(g * 64 + r) * NTOK + tb + k0 + 8 * h, pack8(s, 0), pack8(s, 1));
    }
    float lsum = st.l + __shfl_xor(st.l, 32); lsum += __builtin_amdgcn_exp2f(sk - st.m);
    const float rl = 1.f / lsum;
#pragma unroll
    for (int bb = 0; bb < 2; ++bb)
#pragma unroll
        for (int reg = 0; reg < 16; ++reg) o[bb][reg] *= rl;
    store_o<2>(o, (bf16_t*)(A.ws + WS_BR) + (tb + qpos) * 512 + hd * 64, h);
}
DI void attn_c_task(const MArgs& A, int l, int task, int lane) {
    asm volatile("" : "+v"(lane));
    const int r = lane & 31, h = lane >> 5; const int hf = task & 1, row = (task >> 1) & 31, hd = (task >> 6) & 7, b = task >> 9;
    const int qc = 32 * hf + r, qpos = row * 64 + qc; const size_t tb = (size_t)b * SEQ;
    const int rs = min(max(row - 4, 0), 24), cs = min(max(qc - 8, 0), 48);
    const bf16_t* QC = (const bf16_t*)(A.ws + WS_QC); const bf16_t* KC = (const bf16_t*)(A.ws + WS_KC); const bf16_t* VT = (const bf16_t*)(A.ws + WS_VT);
    const float* rpb = A.in[8] + ((size_t)l * 8 + hd) * 15 * 31;
    bf16x8 qf[4]; load_qf(qf, QC + (tb + qpos) * 512 + hd * 64 + 8 * h);
    f32x16 o[2]; zero_o<2>(o); SoftState st{-1e30f, 0.f};
    const int kp = kperm(r);
    for (int t = 0; t < 16; ++t) {
        const int kr = rs + (t >> 1), c0 = 32 * (t & 1), k0 = kr * 64 + c0;
        f32x16 s = qk_tile(KC + (tb + k0 + kp) * 512 + hd * 64 + 8 * h, qf);
        const float* rp = rpb + (kr - row + 7) * 31 + 15 - qc;
#pragma unroll
        for (int reg = 0; reg < 16; ++reg) { const int kc = c0 + 16 * (reg >> 3) + 8 * h + (reg & 7); const bool ok = kc >= cs && kc < cs + 16;
            const float bias = rp[ok ? kc : qc] * LOG2E; s[reg] = ok ? s[reg] + bias : -INFINITY; }
        soft_tile<2>(s, st, o);
        pv_tile<2>(o, VT + (size_t)(640 + hd * 64 + r) * NTOK + tb + k0 + 8 * h, pack8(s, 0), pack8(s, 1));
    }
    const float l_ = st.l + __shfl_xor(st.l, 32); const float rl = 1.f / l_;
#pragma unroll
    for (int bb = 0; bb < 2; ++bb)
#pragma unroll
        for (int reg = 0; reg < 16; ++reg) o[bb][reg] *= rl;
    store_o<2>(o, (bf16_t*)(A.ws + WS_BR) + (size_t)2 * NTOK * 512 + (tb + qpos) * 512 + hd * 64, h);
}
DI void attn_b_task(const MArgs& A, int l, int task, int lane) {
    asm volatile("" : "+v"(lane));
    const int r = lane & 31, h = lane >> 5; const int qt = task & 63, hd = (task >> 6) & 3, b = task >> 8;
    const int q0 = qt * 32, qpos = q0 + r; const size_t tb = (size_t)b * SEQ;
    const bf16_t* QB = (const bf16_t*)(A.ws + WS_QB); const bf16_t* KB = (const bf16_t*)(A.ws + WS_KB); const bf16_t* VT = (const bf16_t*)(A.ws + WS_VT);
    const float lam_init = 0.8f - 0.6f * __expf(-0.3f * (float)l);
    const float lam = __expf(wave_sum(A.in[3][l * 64 + lane] * A.in[4][l * 64 + lane])) - __expf(wave_sum(A.in[5][l * 64 + lane] * A.in[6][l * 64 + lane])) + lam_init;
    const float slope = exp2f(-8.f * (float)(8 + hd + 1) / 12.f) * LOG2E;
    bf16x8 q1[4], q2[4]; load_qf(q1, QB + (tb + qpos) * 512 + hd * 128 + 8 * h); load_qf(q2, QB + (tb + qpos) * 512 + hd * 128 + 64 + 8 * h);
    f32x16 o1[4], o2[4]; zero_o<4>(o1); zero_o<4>(o2); SoftState s1{-1e30f, 0.f}, s2{-1e30f, 0.f};
    const int kp = kperm(r);
    const bf16_t* kbase = KB + (tb + kp) * 512 + hd * 128 + 8 * h; const bf16_t* vbase = VT + (size_t)(128 + hd * 128 + r) * NTOK + tb + 8 * h;
    for (int t = 0; t < 64; ++t) {
        const int k0 = 32 * t; const float dbase = (float)(k0 + 8 * h - qpos);
        f32x16 sa = qk_tile(kbase + (size_t)k0 * 512, q1);
#pragma unroll
        for (int reg = 0; reg < 16; ++reg) sa[reg] -= slope * fabsf(dbase + (float)(16 * (reg >> 3) + (reg & 7)));
        soft_tile<4>(sa, s1, o1);
        const bf16x8 pa0 = pack8(sa, 0), pa1 = pack8(sa, 1);
        f32x16 sb = qk_tile(kbase + (size_t)k0 * 512 + 64, q2);
#pragma unroll
        for (int reg = 0; reg < 16; ++reg) sb[reg] -= slope * fabsf(dbase + (float)(16 * (reg >> 3) + (reg & 7)));
        soft_tile<4>(sb, s2, o2);
        const bf16x8 pb0 = pack8(sb, 0), pb1 = pack8(sb, 1);
#pragma unroll
        for (int bb = 0; bb < 4; ++bb) {
            const bf16x8 v0 = *(const bf16x8*)(vbase + (size_t)(32 * bb) * NTOK + k0), v1 = *(const bf16x8*)(vbase + (size_t)(32 * bb) * NTOK + k0 + 16);
            o1[bb] = MFMA32(v0, pa0, o1[bb]); o1[bb] = MFMA32(v1, pa1, o1[bb]);
            o2[bb] = MFMA32(v0, pb0, o2[bb]); o2[bb] = MFMA32(v1, pb1, o2[bb]);
        }
    }
    const float r1 = 1.f / (s1.l + __shfl_xor(s1.l, 32)), r2 = lam / (s2.l + __shfl_xor(s2.l, 32));
    float ssq = 0.f;
#pragma unroll
    for (int bb = 0; bb < 4; ++bb)
#pragma unroll
        for (int reg = 0; reg < 16; ++reg) { const float v = o1[bb][reg] * r1 - o2[bb][reg] * r2; o1[bb][reg] = v; ssq += v * v; }
    ssq += __shfl_xor(ssq, 32);
    const float rr = rsqrtf(ssq * (1.f / 128.f) + LN_EPS) * (1.f - lam_init);
    const float* gain = A.in[7] + l * 128;
#pragma unroll
    for (int bb = 0; bb < 4; ++bb)
#pragma unroll
        for (int g4 = 0; g4 < 4; ++g4) { const f32x4 gv = *(const f32x4*)(gain + 32 * bb + 8 * g4 + 4 * h);
            o1[bb][4 * g4] *= rr * gv.x; o1[bb][4 * g4 + 1] *= rr * gv.y; o1[bb][4 * g4 + 2] *= rr * gv.z; o1[bb][4 * g4 + 3] *= rr * gv.w; }
    store_o<4>(o1, (bf16_t*)(A.ws + WS_BR) + (size_t)NTOK * 512 + (tb + qpos) * 512 + hd * 128, h);
}

DI void router_block(const MArgs& A, int l, int vb, LAS unsigned char* lds, int tid, int wave, int lane) {
    const float* Y = (const float*)(A.ws + WS_Y); float* X1F = (float*)(A.ws + WS_X1F); bf16_t* X1B = (bf16_t*)(A.ws + WS_X1B);
    for (int i = wave; i < 64; i += NWAVES) { const size_t row = (size_t)(vb * 64 + i);
        ln_row(Y + row * DM, A.in[11] + l * DM, A.in[12] + l * DM, X1F + row * DM, X1B + row * DM, lane); }
    __syncthreads();
    LAS float* part = (LAS float*)lds;
    LAS int* lh = (LAS int*)(lds + 16384);
    if (tid < 32) lh[tid] = 0;
    {
        const int tg = wave & 3, kh = wave >> 2, i = lane & 15, kq = lane >> 4;
        const float* xr = X1F + (size_t)(vb * 64 + tg * 16 + i) * DM + kh * 512 + 4 * kq;
        const float* wr = A.in[13] + (size_t)l * DM * 32 + (size_t)(kh * 512 + 4 * kq) * 32 + i;
        f32x4 acc0 = {0.f, 0.f, 0.f, 0.f}, acc1 = {0.f, 0.f, 0.f, 0.f};
#pragma unroll 4
        for (int gk = 0; gk < 32; ++gk) {
            const f32x4 a4 = *(const f32x4*)(xr + 16 * gk);
#pragma unroll
            for (int u = 0; u < 4; ++u) { const float b0 = wr[(16 * gk + u) * 32], b1 = wr[(16 * gk + u) * 32 + 16];
                acc0 = __builtin_amdgcn_mfma_f32_16x16x4f32(a4[u], b0, acc0, 0, 0, 0); acc1 = __builtin_amdgcn_mfma_f32_16x16x4f32(a4[u], b1, acc1, 0, 0, 0); }
        }
#pragma unroll
        for (int reg = 0; reg < 4; ++reg) { const int tk = tg * 16 + 4 * kq + reg; part[(kh * 64 + tk) * 32 + i] = acc0[reg]; part[(kh * 64 + tk) * 32 + 16 + i] = acc1[reg]; }
    }
    __syncthreads();
    if (tid < 64) {
        float lg[32]; const float* br = A.in[14] + l * 32;
#pragma unroll
        for (int e = 0; e < 32; ++e) lg[e] = part[tid * 32 + e] + part[(64 + tid) * 32 + e] + br[e];
        int idx[4]; float val[4];
#pragma unroll
        for (int k = 0; k < 4; ++k) { float best = -INFINITY; int bi = 0;
#pragma unroll
            for (int e = 0; e < 32; ++e) { const bool taken = (k > 0 && idx[0] == e) || (k > 1 && idx[1] == e) || (k > 2 && idx[2] == e); if (!taken && lg[e] > best) { best = lg[e]; bi = e; } }
            idx[k] = bi; val[k] = best; }
        float ls = 0.f, ex[4];
#pragma unroll
        for (int k = 0; k < 4; ++k) { ex[k] = __expf(val[k] - val[0]); ls += ex[k]; }
        int* ti = (int*)(A.ws + WS_TOPI) + (vb * 64 + tid) * 4; float* tw = (float*)(A.ws + WS_TOPW) + (vb * 64 + tid) * 4;
#pragma unroll
        for (int k = 0; k < 4; ++k) { ti[k] = idx[k]; tw[k] = ex[k] / ls; __hip_atomic_fetch_add(&lh[idx[k]], 1, __ATOMIC_RELAXED, __HIP_MEMORY_SCOPE_WORKGROUP); }
    }
    __syncthreads();
    if (tid < 32) ((int*)(A.ws + WS_HIST))[vb * 32 + tid] = lh[tid];
    __syncthreads();
}
DI void dispatch_fast(unsigned char* ws, int vb, LAS int* L, int tid, int nthr) {
    const int* hist = (const int*)(ws + WS_HIST); const int* topi = (const int*)(ws + WS_TOPI); const float* topw = (const float*)(ws + WS_TOPW);
    int* tslot = (int*)(ws + WS_TSLOT); int* rtok = (int*)(ws + WS_RTOK); float* rw = (float*)(ws + WS_RW); int* pane = (int*)(ws + WS_PANE);
    LAS int* pc = L; LAS int* pb = L + 512; LAS int* cnt = L + 1024; LAS int* base = L + 1056; LAS int* pstart = L + 1088; LAS int* npan = L + 1120;
    LAS int* sidx = L + 1152; LAS float* sw = (LAS float*)(L + 1408); LAS int* sslot = L + 1664;
    { const int e = tid & 31, ch = tid >> 5, nch = nthr >> 5; int c = 0, bs = 0;
        for (int b2 = ch; b2 < NRB; b2 += nch) { const int hv = hist[b2 * 32 + e]; c += hv; if (b2 < vb) bs += hv; }
        pc[ch * 32 + e] = c; pb[ch * 32 + e] = bs; }
    if (tid < 256) { sidx[tid] = topi[vb * 256 + tid]; sw[tid] = topw[vb * 256 + tid]; }
    __syncthreads();
    if (tid < 32) { const int nch = nthr >> 5; int c = 0, bs = 0; for (int ch = 0; ch < nch; ++ch) { c += pc[ch * 32 + tid]; bs += pb[ch * 32 + tid]; } cnt[tid] = c; base[tid] = bs; }
    __syncthreads();
    if (tid == 0) { int acc = 0; for (int e = 0; e < 32; ++e) { pstart[e] = acc; acc += ((cnt[e] + 255) >> 8) << 8; } npan[0] = acc >> 8; }
    __syncthreads();
    if (tid < 32) {
        const int e = tid; int slot = pstart[e] + base[e];
        for (int a = 0; a < 256; ++a) { if (sidx[a] == e) { sslot[a] = slot; rtok[slot] = vb * 64 + (a >> 2); rw[slot] = sw[a]; ++slot; } }
        if (vb == 0) { const int p0 = pstart[e] >> 8, p1 = p0 + ((cnt[e] + 255) >> 8); for (int p = p0; p < p1; ++p) pane[p] = e; if (e == 0) pane[511] = npan[0]; }
    }
    __syncthreads();
    if (tid < 256) tslot[vb * 256 + tid] = sslot[tid];
    const bf16_t* x1b = (const bf16_t*)(ws + WS_X1B); bf16_t* xs = (bf16_t*)(ws + WS_XS);
    for (int i = tid; i < 256 * 128; i += nthr) { const int a = i >> 7, c = i & 127; const int slot = sslot[a];
        *(u32x4_t*)(xs + (size_t)slot * DM + 8 * c) = *(const u32x4_t*)(x1b + (size_t)(vb * 64 + (a >> 2)) * DM + 8 * c); }
    __syncthreads();
}

typedef const __attribute__((address_space(4))) MArgs* kargs_ptr;
DI MArgs load_margs(kargs_ptr p) { MArgs a;
#pragma unroll
    for (int i = 0; i < 21; ++i) a.in[i] = p->in[i];
    a.out = p->out; a.ws = p->ws; a.ph_lo = p->ph_lo; a.ph_hi = p->ph_hi; return a; }
#define PHASE_ARGS() kargs_ptr ap_ = (kargs_ptr)__builtin_amdgcn_kernarg_segment_ptr(); asm volatile("" : "+s"(ap_)); const MArgs A = load_margs(ap_); \
    int gw = gw0, vcu = vcu0, bx = bx0, tid = tid0, lane = lane0, wave = wave0; asm volatile("" : "+s"(gw), "+s"(vcu), "+s"(bx), "+s"(wave), "+v"(tid), "+v"(lane))
__global__ void __launch_bounds__(NTHREADS, 2) mega(MArgs A_unused) {
    extern __shared__ __attribute__((aligned(16))) unsigned char lds_raw[];
    LAS unsigned char* lds = (LAS unsigned char*)lds_raw;
    const int tid0 = threadIdx.x, lane0 = tid0 & 63, wave0 = __builtin_amdgcn_readfirstlane(tid0 >> 6);
    const int G = gridDim.x, bx0 = blockIdx.x, vcu0 = (G % 8 == 0) ? (bx0 % 8) * (G / 8) + bx0 / 8 : bx0;
    const int gw0 = vcu0 * NWAVES + wave0, ngw = G * NWAVES;
    volatile LAS unsigned* misc = (volatile LAS unsigned*)(lds + LDS_MISC);
    if (tid0 < 64) misc[tid0] = 0u;
    __syncthreads();
    int lo, hi; XcdBarrier bar;
    { PHASE_ARGS(); (void)gw; (void)vcu; (void)bx; (void)tid; (void)lane; (void)wave; lo = A.ph_lo; hi = A.ph_hi; bar = xcd_barrier_post((unsigned*)(A.ws + WS_CTL) + CW_BAR, misc + 8); }
#define IN(k) (lo <= (k) && (k) < hi)
#define SEAM(k) do { if (IN(k) && IN((k) + 1)) xcd_barrier(bar); } while (0)
    if (IN(0)) { PHASE_ARGS(); prologue_phase(A, lds, gw, ngw, wave, lane); }
    SEAM(0);
    for (int l = 0; l < 2; ++l) {
        const int pb = 1 + 9 * l;
        if (IN(pb + 0)) {
            PHASE_ARGS(); const pg8::Gemm gm{(const bf16_t*)A.ws, (const bf16_t*)A.ws, 0, 0, DM};
            const int xb0 = (int)(WS_XB >> 19), w0 = (int)((WS_W + (size_t)l * WL_BYTES + WL_IN) >> 19);
            SchedInProj S; S.so.init(NTOK, 28 * 256, G, bx); S.xb0 = xb0; S.w0 = w0;
            EpiInProj E{A.ws, xb0, w0};
            pg8::gemm_phase<EpiInProj, SchedInProj, true, true>(lds, gm, S, E);
        }
        SEAM(pb + 0);
        if (IN(pb + 1)) {
            PHASE_ARGS();
            for (int t = gw; t < 2048; t += ngw) attn_b_task(A, l, t, lane);
            for (int t = gw; t < 4096; t += ngw) attn_a_task(A, l, t, lane);
            for (int t = gw; t < 4096; t += ngw) attn_c_task(A, l, t, lane);
        }
        SEAM(pb + 1);
        if (IN(pb + 2)) {
            PHASE_ARGS(); const pg8::Gemm gm512{(const bf16_t*)A.ws, (const bf16_t*)A.ws, 0, 0, 512};
            const int a0 = (int)(WS_BR >> 18), b0 = (int)((WS_W + (size_t)l * WL_BYTES + WL_BR) >> 18);
            SchedBranch S{vcu, G, a0, b0};
            EpiBranch E{A.ws, a0, b0};
            pg8::gemm_phase<EpiBranch, SchedBranch, false, true>(lds, gm512, S, E);
        }
        SEAM(pb + 2);
        if (IN(pb + 3)) {
            PHASE_ARGS(); const pg8::Gemm gm{(const bf16_t*)A.ws, (const bf16_t*)A.ws, 0, 0, DM};
            const float* xcur = l == 0 ? A.in[0] : (const float*)(A.ws + WS_XF);
            const int a0 = (int)(WS_MB >> 19), b0 = (int)((WS_W + (size_t)l * WL_BYTES + WL_OUT) >> 19);
            SchedPlain S; S.so.init(NTOK, DM, G, bx); S.a0 = a0; S.b0 = b0;
            EpiWout E{xcur, (float*)(A.ws + WS_Y), a0, b0};
            pg8::gemm_phase<EpiWout, SchedPlain, false, true>(lds, gm, S, E);
        }
        SEAM(pb + 3);
        if (IN(pb + 4)) { PHASE_ARGS(); for (int vb = vcu; vb < NRB; vb += G) router_block(A, l, vb, lds, tid, wave, lane); }
        SEAM(pb + 4);
        if (IN(pb + 5)) { PHASE_ARGS(); for (int vb = vcu; vb < NRB; vb += G) dispatch_fast(A.ws, vb, (LAS int*)lds, tid, NTHREADS); }
        SEAM(pb + 5);
        if (IN(pb + 6)) {
            PHASE_ARGS(); const pg8::Gemm gm{(const bf16_t*)A.ws, (const bf16_t*)A.ws, 0, 0, DM};
            const int* pane = (const int*)(A.ws + WS_PANE); const int np = __builtin_amdgcn_readfirstlane(pane[511]);
            const int a0 = (int)(WS_XS >> 19), b0 = (int)((WS_W + (size_t)l * WL_BYTES + WL_UP) >> 19);
            SchedMoe S{pane, 8, a0, b0, G, bx, np * 8};
            EpiUp E{A.ws, A.in[16] + (size_t)l * NE * 2048, a0, b0};
            pg8::gemm_phase<EpiUp, SchedMoe, true, true>(lds, gm, S, E);
        }
        SEAM(pb + 6);
        if (IN(pb + 7)) {
            PHASE_ARGS(); const pg8::Gemm gm{(const bf16_t*)A.ws, (const bf16_t*)A.ws, 0, 0, DM};
            const int* pane = (const int*)(A.ws + WS_PANE); const int np = __builtin_amdgcn_readfirstlane(pane[511]);
            const int a0 = (int)(WS_ACTB >> 19), b0 = (int)((WS_W + (size_t)l * WL_BYTES + WL_DN) >> 19);
            SchedMoe S{pane, 4, a0, b0, G, bx, np * 4};
            EpiDown E{A.ws, A.in[18] + (size_t)l * NE * DM, a0, b0};
            pg8::gemm_phase<EpiDown, SchedMoe, true, true>(lds, gm, S, E);
        }
        SEAM(pb + 7);
        if (IN(pb + 8)) {
            PHASE_ARGS();
            float* outF = l == 0 ? (float*)(A.ws + WS_XF) : A.out; bf16_t* outB = l == 0 ? (bf16_t*)(A.ws + WS_XB) : nullptr;
            for (int tok = gw; tok < NTOK; tok += ngw) combine_row(A.ws, tok, A.in[19] + l * DM, A.in[20] + l * DM, outF, outB, lane);
        }
        SEAM(pb + 8);
    }
#undef IN
#undef SEAM
}

#ifndef FASTMASK
#define FASTMASK 0x1FF
#endif
#ifndef ONE_LAUNCH
#define ONE_LAUNCH 1
#endif
static void launch_mega(const MArgs& a0, int lo, int hi, hipStream_t stream) {
    MArgs a = a0; a.ph_lo = lo; a.ph_hi = hi;
    hipLaunchKernelGGL(mega, dim3(256), dim3(NTHREADS), LDS_BYTES, stream, a);
}
extern "C" void kernel_launch(void* const* d_in, const int* in_sizes, int n_in, void* d_out, int out_size, void* d_ws, size_t ws_size, hipStream_t stream) {
    if (n_in != 21 || ws_size < WS_END) { fprintf(stderr, "kernel_launch: unexpected inputs (n_in %d, ws %zu)\n", n_in, ws_size); return; }
    static int ready = 0;
    if (!ready) { if (hipFuncSetAttribute((const void*)mega, hipFuncAttributeMaxDynamicSharedMemorySize, LDS_BYTES) != hipSuccess) { fprintf(stderr, "hipFuncSetAttribute failed\n"); } ready = 1; }
    unsigned char* ws = (unsigned char*)d_ws;
    const float* x_in = (const float*)d_in[0];
    (void)hipMemsetAsync(ws + WS_CTL, 0, 1 * MiB, stream);
    MArgs ma{};
    for (int i = 0; i < 21; ++i) ma.in[i] = (const float*)d_in[i];
    ma.out = (float*)d_out; ma.ws = ws;
    if (ONE_LAUNCH) { launch_mega(ma, 0, NPHASE, stream); return; }
    const unsigned fm = FASTMASK;
    if (fm) launch_mega(ma, 0, 1, stream);
    for (int l = 0; l < 2; ++l) {
        const int pb = 1 + 9 * l;
        const float* xcur = l == 0 ? x_in : (const float*)(ws + WS_XF);
        float* xnext = l == 0 ? (float*)(ws + WS_XF) : (float*)d_out;
        const float* w_in = (const float*)d_in[1] + (size_t)l * DM * IN_W;
        const float* a_sink = (const float*)d_in[2] + l * 8;
        const float* lq1 = (const float*)d_in[3] + l * 64; const float* lk1 = (const float*)d_in[4] + l * 64;
        const float* lq2 = (const float*)d_in[5] + l * 64; const float* lk2 = (const float*)d_in[6] + l * 64;
        const float* dng = (const float*)d_in[7] + l * 128;
        const float* rpb = (const float*)d_in[8] + (size_t)l * 8 * 15 * 31;
        const float* w_br = (const float*)d_in[9] + (size_t)l * 3 * 512 * DM;
        const float* w_out = (const float*)d_in[10] + (size_t)l * DM * DM;
        const float* ln1g = (const float*)d_in[11] + l * DM; const float* ln1b = (const float*)d_in[12] + l * DM;
        const float* w_r = (const float*)d_in[13] + (size_t)l * DM * 32; const float* b_r = (const float*)d_in[14] + l * 32;
        const float* w_up = (const float*)d_in[15] + (size_t)l * NE * DM * 2048; const float* b_up = (const float*)d_in[16] + (size_t)l * NE * 2048;
        const float* w_dn = (const float*)d_in[17] + (size_t)l * NE * FE * DM; const float* b_dn = (const float*)d_in[18] + (size_t)l * NE * DM;
        const float* ln2g = (const float*)d_in[19] + l * DM; const float* ln2b = (const float*)d_in[20] + l * DM;
        const float lam_init = 0.8f - 0.6f * expf(-0.3f * (float)l);
        if (fm & 1) launch_mega(ma, pb + 0, pb + 1, stream);
        else nv_gemm<AF32, BKN, EInProj, 1><<<dim3(IN_W / 64, NTOK / 64), 256, 0, stream>>>(AF32{xcur, DM}, BKN{w_in, IN_W, 0}, EInProj{ws}, nullptr, NTOK, IN_W, DM, 0);
        if (fm & 2) launch_mega(ma, pb + 1, pb + 2, stream);
        else {
            nv_attn_a<<<NTOK * 8 / 4, 256, 0, stream>>>((const bf16_t*)(ws + WS_QA), (const bf16_t*)(ws + WS_KA), (const bf16_t*)(ws + WS_VT), (bf16_t*)(ws + WS_BR), a_sink);
            nv_attn_b<<<NTOK * 4 / 4, 256, 0, stream>>>((const bf16_t*)(ws + WS_QB), (const bf16_t*)(ws + WS_KB), (const bf16_t*)(ws + WS_VT), (bf16_t*)(ws + WS_BR) + (size_t)NTOK * 512, lq1, lk1, lq2, lk2, dng, lam_init);
            nv_attn_c<<<NTOK * 8 / 4, 256, 0, stream>>>((const bf16_t*)(ws + WS_QC), (const bf16_t*)(ws + WS_KC), (const bf16_t*)(ws + WS_VT), (bf16_t*)(ws + WS_BR) + (size_t)2 * NTOK * 512, rpb);
        }
        if (fm & 4) launch_mega(ma, pb + 2, pb + 3, stream);
        else for (int i = 0; i < 3; ++i)
            nv_gemm<ABF, BKN, EBranch, 1><<<dim3(DM / 64, NTOK / 64), 256, 0, stream>>>(ABF{(const bf16_t*)(ws + WS_BR) + (size_t)i * NTOK * 512, 512}, BKN{w_br + (size_t)i * 512 * DM, DM, 0}, EBranch{ws, i}, nullptr, NTOK, DM, 512, 0);
        if (fm & 8) launch_mega(ma, pb + 3, pb + 4, stream);
        else nv_gemm<AF32, BKN, EWout, 1><<<dim3(DM / 64, NTOK / 64), 256, 0, stream>>>(AF32{(const float*)(ws + WS_MF), DM}, BKN{w_out, DM, 0}, EWout{xcur, (float*)(ws + WS_Y)}, nullptr, NTOK, DM, DM, 0);
        if (fm & 16) launch_mega(ma, pb + 4, pb + 5, stream);
        else {
            k_ln1<<<NTOK / 4, 256, 0, stream>>>((const float*)(ws + WS_Y), ln1g, ln1b, (float*)(ws + WS_X1F), (bf16_t*)(ws + WS_X1B));
            k_router_naive<<<NTOK * 32 / 256, 256, 0, stream>>>((const float*)(ws + WS_X1F), w_r, b_r, (float*)(ws + WS_LOGIT));
            k_topk<<<NTOK / 256, 256, 0, stream>>>((const float*)(ws + WS_LOGIT), (int*)(ws + WS_TOPI), (float*)(ws + WS_TOPW));
            k_hist<<<NRB, 256, 0, stream>>>(ws);
        }
        (void)hipMemsetAsync(ws + WS_RTOK, 0xFF, NPADROWS * 4, stream);
        if (fm & 32) launch_mega(ma, pb + 5, pb + 6, stream);
        else k_dispatch<<<NRB, 256, 0, stream>>>(ws);
        if (fm & 64) launch_mega(ma, pb + 6, pb + 7, stream);
        else nv_gemm<AGather, BExp, EUp, 2><<<dim3(FE / 64, NPADROWS / 64), 256, 0, stream>>>(AGather{(const float*)(ws + WS_X1F), (const int*)(ws + WS_RTOK)},
            BExp{w_up, (const int*)(ws + WS_PANE), (size_t)DM * 2048, 2048, 1024}, EUp{b_up, (const int*)(ws + WS_PANE), (bf16_t*)(ws + WS_ACTB)}, (const int*)(ws + WS_PANE) + 511, NPADROWS, FE, DM, 0);
        if (fm & 128) launch_mega(ma, pb + 7, pb + 8, stream);
        else nv_gemm<ABF, BExp, EDown, 1><<<dim3(DM / 64, NPADROWS / 64), 256, 0, stream>>>(ABF{(const bf16_t*)(ws + WS_ACTB), FE},
            BExp{w_dn, (const int*)(ws + WS_PANE), (size_t)FE * DM, DM, 0}, EDown{b_dn, (const int*)(ws + WS_PANE), (const float*)(ws + WS_RW), (bf16_t*)(ws + WS_YS)}, (const int*)(ws + WS_PANE) + 511, NPADROWS, DM, FE, 0);
        if (fm & 256) launch_mega(ma, pb + 8, pb + 9, stream);
        else k_combine<<<NTOK / 4, 256, 0, stream>>>(ws, ln2g, ln2b, xnext, l == 0 ? (bf16_t*)(ws + WS_XB) : nullptr);
    }
}
```

```cpp
#include <hip/hip_runtime.h>
#include <stdint.h>
#include <stdio.h>

#define DI __device__ __forceinline__
#ifndef PROBE_REP
#define PROBE_REP 0
#endif
typedef unsigned short bf16_t;
typedef unsigned u32x4_t __attribute__((ext_vector_type(4)));

constexpr int NTOK = 16384, DM = 1024, SEQ = 2048, NBATCH = 8;
constexpr int IN_W = 6912;
constexpr int NE = 32, TOPK = 4, FE = 1024;
constexpr int MAXPANELS = 288;
constexpr int NPADROWS = MAXPANELS * 256;
constexpr float LOG2E = 1.4426950408889634f;
constexpr float C2 = 0.125f * 1.4426950408889634f;
constexpr float DN_ALPHA = 1.4142135623730951f;
constexpr float LN_EPS = 1e-5f;
constexpr float SWI_LIMIT = 7.0f, SWI_ALPHA = 1.702f;
constexpr int NRB = 256;

constexpr size_t MiB = 1u << 20;
constexpr size_t WS_CTL = 0;
constexpr size_t WS_TOPI = 1 * MiB;
constexpr size_t WS_TOPW = WS_TOPI + 256 * 1024;
constexpr size_t WS_TSLOT = WS_TOPW + 256 * 1024;
constexpr size_t WS_RTOK = WS_TSLOT + 256 * 1024;
constexpr size_t WS_RW = WS_RTOK + 512 * 1024;
constexpr size_t WS_HIST = WS_RW + 512 * 1024;
constexpr size_t WS_PANE = WS_HIST + 64 * 1024;
constexpr size_t WS_LOGIT = 4 * MiB;
constexpr size_t WS_W = 8 * MiB;
constexpr size_t WL_IN = 0, WL_OUT = 14 * MiB, WL_BR = 16 * MiB, WL_UP = 19 * MiB, WL_DN = 147 * MiB, WL_BYTES = 211 * MiB;
constexpr size_t WS_ACT = WS_W + 2 * WL_BYTES;
constexpr size_t WS_XB = WS_ACT;
constexpr size_t WS_XF = WS_XB + 32 * MiB;
constexpr size_t WS_QA = WS_XF + 64 * MiB;
constexpr size_t WS_KA = WS_QA + 16 * MiB;
constexpr size_t WS_QB = WS_KA + 4 * MiB;
constexpr size_t WS_KB = WS_QB + 16 * MiB;
constexpr size_t WS_QC = WS_KB + 16 * MiB;
constexpr size_t WS_KC = WS_QC + 16 * MiB;
constexpr size_t WS_G = WS_KC + 16 * MiB;
constexpr size_t WS_VT = WS_G + 96 * MiB;
constexpr size_t WS_BR = WS_VT + 40 * MiB;
constexpr size_t WS_MF = WS_BR + 48 * MiB;
constexpr size_t WS_MB = WS_MF + 64 * MiB;
constexpr size_t WS_Y = WS_MB + 32 * MiB;
constexpr size_t WS_X1F = WS_Y + 64 * MiB;
constexpr size_t WS_X1B = WS_X1F + 64 * MiB;
constexpr size_t WS_XS = WS_X1B + 32 * MiB;
constexpr size_t WS_ACTB = WS_XS + 144 * MiB;
constexpr size_t WS_YS = WS_ACTB + 144 * MiB;
constexpr size_t WS_END = WS_YS + 144 * MiB;
static_assert(WS_END <= 2048 * MiB, "workspace map");

DI float bf2f(bf16_t v) { return __uint_as_float(((unsigned)v) << 16); }
DI bf16_t f2bf(float f) { unsigned u = __float_as_uint(f); return (bf16_t)((u + 0x7fffu + ((u >> 16) & 1u)) >> 16); }
template <int CTRL> DI float dppf(float v) { return __int_as_float(__builtin_amdgcn_update_dpp(0, __float_as_int(v), CTRL, 0xF, 0xF, true)); }
DI float wave_sum(float v) {
    v += dppf<0xB1>(v); v += dppf<0x4E>(v); v += dppf<0x141>(v); v += dppf<0x140>(v);
    { auto r = __builtin_amdgcn_permlane16_swap(__float_as_uint(v), __float_as_uint(v), false, false); v = __uint_as_float(r[0]) + __uint_as_float(r[1]); }
    { auto r = __builtin_amdgcn_permlane32_swap(__float_as_uint(v), __float_as_uint(v), false, false); v = __uint_as_float(r[0]) + __uint_as_float(r[1]); }
    return v;
}
DI float wave_max(float v) {
    v = fmaxf(v, dppf<0xB1>(v)); v = fmaxf(v, dppf<0x4E>(v)); v = fmaxf(v, dppf<0x141>(v)); v = fmaxf(v, dppf<0x140>(v));
    { auto r = __builtin_amdgcn_permlane16_swap(__float_as_uint(v), __float_as_uint(v), false, false); v = fmaxf(__uint_as_float(r[0]), __uint_as_float(r[1])); }
    { auto r = __builtin_amdgcn_permlane32_swap(__float_as_uint(v), __float_as_uint(v), false, false); v = fmaxf(__uint_as_float(r[0]), __uint_as_float(r[1])); }
    return v;
}
DI float sigmoidf_(float x) { return 1.f / (1.f + __expf(-x)); }
DI float dot64_bf(const float (&q)[64], const bf16_t* kp) {
    float acc = 0.f;
#pragma unroll
    for (int c = 0; c < 8; ++c) {
        const u32x4_t v = *(const u32x4_t*)(kp + 8 * c);
#pragma unroll
        for (int i = 0; i < 4; ++i) {
            acc += q[8 * c + 2 * i] * __uint_as_float(v[i] << 16);
            acc += q[8 * c + 2 * i + 1] * __uint_as_float(v[i] & 0xffff0000u);
        }
    }
    return acc;
}
DI void load_q64(float (&q)[64], const bf16_t* qp) {
#pragma unroll
    for (int c = 0; c < 8; ++c) {
        const u32x4_t v = *(const u32x4_t*)(qp + 8 * c);
#pragma unroll
        for (int i = 0; i < 4; ++i) { q[8 * c + 2 * i] = __uint_as_float(v[i] << 16); q[8 * c + 2 * i + 1] = __uint_as_float(v[i] & 0xffff0000u); }
    }
}

struct AF32 { const float* p; int ld; int pad; DI float operator()(int m, int k) const { return p[(size_t)m * ld + k]; } };
struct ABF { const bf16_t* p; int ld; int pad; DI float operator()(int m, int k) const { return bf2f(p[(size_t)m * ld + k]); } };
struct AGather { const float* x; const int* row_tok; DI float operator()(int m, int k) const { const int t = row_tok[m]; return (t < 0 || t >= NTOK) ? 0.f : x[(size_t)t * DM + k]; } };
struct BKN { const float* p; int ld; int off2; DI float operator()(int a, int, int k, int n) const { return p[(size_t)k * ld + n + a * off2]; } };
struct BExp { const float* w; const int* panel_e; size_t estride; int ld; int off2;
    DI float operator()(int a, int m0, int k, int n) const { const int e = panel_e[m0 >> 8]; return w[(size_t)e * estride + (size_t)k * ld + n + a * off2]; } };

template <class AF, class BF, class EF, int NACC>
__global__ void __launch_bounds__(256) nv_gemm(AF af, BF bf, EF ef, const int* mlimit, int M, int N, int K, int pad) {
    __shared__ float As[16][65];
    __shared__ float Bs[NACC][16][65];
    const int m0 = blockIdx.y * 64, n0 = blockIdx.x * 64;
    if (mlimit && m0 >= (*mlimit) * 256) return;
    const int tx = threadIdx.x & 15, ty = threadIdx.x >> 4;
    float acc[NACC][4][4];
#pragma unroll
    for (int a = 0; a < NACC; ++a)
#pragma unroll
        for (int i = 0; i < 4; ++i)
#pragma unroll
            for (int j = 0; j < 4; ++j) acc[a][i][j] = 0.f;
    for (int k0 = 0; k0 < K; k0 += 16) {
#pragma unroll
        for (int i = 0; i < 4; ++i) {
            const int t = threadIdx.x + i * 256;
            { const int m = t >> 4, k = t & 15; As[k][m] = af(m0 + m, k0 + k); }
            { const int k = t >> 6, n = t & 63;
#pragma unroll
                for (int a = 0; a < NACC; ++a) Bs[a][k][n] = (n0 + n < N) ? bf(a, m0, k0 + k, n0 + n) : 0.f; }
        }
        __syncthreads();
#pragma unroll
        for (int kk = 0; kk < 16; ++kk) {
            float av[4], bv[NACC][4];
#pragma unroll
            for (int i = 0; i < 4; ++i) av[i] = As[kk][ty * 4 + i];
#pragma unroll
            for (int a = 0; a < NACC; ++a)
#pragma unroll
                for (int j = 0; j < 4; ++j) bv[a][j] = Bs[a][kk][tx * 4 + j];
#pragma unroll
            for (int a = 0; a < NACC; ++a)
#pragma unroll
                for (int i = 0; i < 4; ++i)
#pragma unroll
                    for (int j = 0; j < 4; ++j) acc[a][i][j] += av[i] * bv[a][j];
        }
        __syncthreads();
    }
#pragma unroll
    for (int i = 0; i < 4; ++i)
#pragma unroll
        for (int j = 0; j < 4; ++j) { const int m = m0 + ty * 4 + i, n = n0 + tx * 4 + j; if (n < N) ef(m, n, acc[0][i][j], acc[NACC - 1][i][j]); }
}

struct EInProj {
    unsigned char* ws;
    DI void operator()(int m, int n, float a, float) const {
        bf16_t* QA = (bf16_t*)(ws + WS_QA); bf16_t* KA = (bf16_t*)(ws + WS_KA); bf16_t* QB = (bf16_t*)(ws + WS_QB); bf16_t* KB = (bf16_t*)(ws + WS_KB);
        bf16_t* QC = (bf16_t*)(ws + WS_QC); bf16_t* KC = (bf16_t*)(ws + WS_KC); bf16_t* G = (bf16_t*)(ws + WS_G); bf16_t* VT = (bf16_t*)(ws + WS_VT);
        if (n < 512) QA[(size_t)m * 512 + n] = f2bf(a * C2);
        else if (n < 640) KA[(size_t)m * 128 + (n - 512)] = f2bf(a);
        else if (n < 768) VT[(size_t)(n - 640) * NTOK + m] = f2bf(a);
        else if (n < 1280) QB[(size_t)m * 512 + (n - 768)] = f2bf(a * C2);
        else if (n < 1792) KB[(size_t)m * 512 + (n - 1280)] = f2bf(a);
        else if (n < 2304) VT[(size_t)(128 + n - 1792) * NTOK + m] = f2bf(a);
        else if (n < 2816) QC[(size_t)m * 512 + (n - 2304)] = f2bf(a * C2);
        else if (n < 3328) KC[(size_t)m * 512 + (n - 2816)] = f2bf(a);
        else if (n < 3840) VT[(size_t)(640 + n - 3328) * NTOK + m] = f2bf(a);
        else G[(size_t)m * 3072 + (n - 3840)] = f2bf(sigmoidf_(a));
    }
};
struct EBranch { unsigned char* ws; int i; int pad;
    DI void operator()(int m, int n, float a, float) const {
        const bf16_t* G = (const bf16_t*)(ws + WS_G); float* MF = (float*)(ws + WS_MF); bf16_t* MB = (bf16_t*)(ws + WS_MB);
        float v = bf2f(G[(size_t)m * 3072 + i * 1024 + n]) * a; const size_t idx = (size_t)m * DM + n;
        if (i > 0) v += MF[idx];
        MF[idx] = v; if (i == 2) MB[idx] = f2bf(v);
    }
};
struct EWout { const float* x; float* Y; DI void operator()(int m, int n, float a, float) const { const size_t idx = (size_t)m * DM + n; Y[idx] = DN_ALPHA * x[idx] + a; } };
struct EUp { const float* b_up; const int* panel_e; bf16_t* ACT;
    DI void operator()(int m, int n, float hg, float hl) const {
        const int e = panel_e[m >> 8]; hg += b_up[e * 2048 + n]; hl += b_up[e * 2048 + 1024 + n];
        hg = fminf(hg, SWI_LIMIT); hl = fminf(fmaxf(hl, -SWI_LIMIT), SWI_LIMIT);
        ACT[(size_t)m * FE + n] = f2bf(hg * sigmoidf_(SWI_ALPHA * hg) * (hl + 1.f));
    }
};
struct EDown { const float* b_dn; const int* panel_e; const float* row_w; bf16_t* YS;
    DI void operator()(int m, int n, float a, float) const { const int e = panel_e[m >> 8]; YS[(size_t)m * DM + n] = f2bf((a + b_dn[e * DM + n]) * row_w[m]); }
};

__global__ void __launch_bounds__(256) nv_attn_a(const bf16_t* QA, const bf16_t* KA, const bf16_t* VT, bf16_t* OA, const float* sink) {
    __shared__ float ps[4][320];
    const int w = threadIdx.x >> 6, lane = threadIdx.x & 63;
    const int item = blockIdx.x * 4 + w, tok = item >> 3, h = item & 7, g = h >> 2, b = tok >> 11, s = tok & 2047;
    float q[64]; load_q64(q, QA + (size_t)tok * 512 + h * 64);
    const float slope = exp2f(-8.f * (float)(h + 1) / 12.f) * LOG2E, sk = sink[h] * LOG2E;
    float sc[5]; float mx = sk;
#pragma unroll
    for (int i = 0; i < 5; ++i) {
        const int j = s - 128 + lane + 64 * i; float v = -INFINITY;
        if (j >= 0 && j < SEQ && j <= s + 128) v = dot64_bf(q, KA + (size_t)(b * SEQ + j) * 128 + g * 64) - slope * fabsf((float)(j - s));
        sc[i] = v; mx = fmaxf(mx, v);
    }
    mx = wave_max(mx);
    float l = 0.f;
#pragma unroll
    for (int i = 0; i < 5; ++i) { sc[i] = exp2f(sc[i] - mx); l += sc[i]; }
    l = wave_sum(l) + exp2f(sk - mx);
    const float rl = 1.f / l;
#pragma unroll
    for (int i = 0; i < 5; ++i) ps[w][lane + 64 * i] = sc[i] * rl;
    __syncthreads();
    float o = 0.f; const bf16_t* vp = VT + (size_t)(g * 64 + lane) * NTOK + (size_t)b * SEQ;
    for (int jj = 0; jj < 320; ++jj) { const int j = s - 128 + jj; if (j >= 0 && j < SEQ) o += ps[w][jj] * bf2f(vp[j]); }
    OA[(size_t)tok * 512 + h * 64 + lane] = f2bf(o);
}
__global__ void __launch_bounds__(256) nv_attn_c(const bf16_t* QC, const bf16_t* KC, const bf16_t* VT, bf16_t* OC, const float* rpb  ) {
    __shared__ float ps[4][128];
    const int w = threadIdx.x >> 6, lane = threadIdx.x & 63;
    const int item = blockIdx.x * 4 + w, tok = item >> 3, h = item & 7, b = tok >> 11, s = tok & 2047;
    const int r = s >> 6, qc = s & 63; const int rs = min(max(r - 4, 0), 24), cs = min(max(qc - 8, 0), 48);
    float q[64]; load_q64(q, QC + (size_t)tok * 512 + h * 64);
    float sc[2]; float mx = -INFINITY;
#pragma unroll
    for (int i = 0; i < 2; ++i) {
        const int kk = lane + 64 * i, kr = rs + (kk >> 4), kc = cs + (kk & 15), j = kr * 64 + kc;
        sc[i] = dot64_bf(q, KC + (size_t)(b * SEQ + j) * 512 + h * 64) + rpb[(h * 15 + (kr - r + 7)) * 31 + (kc - qc + 15)] * LOG2E;
        mx = fmaxf(mx, sc[i]);
    }
    mx = wave_max(mx);
    float l = 0.f;
#pragma unroll
    for (int i = 0; i < 2; ++i) { sc[i] = exp2f(sc[i] - mx); l += sc[i]; }
    l = wave_sum(l); const float rl = 1.f / l;
#pragma unroll
    for (int i = 0; i < 2; ++i) ps[w][lane + 64 * i] = sc[i] * rl;
    __syncthreads();
    float o = 0.f; const bf16_t* vp = VT + (size_t)(640 + h * 64 + lane) * NTOK + (size_t)b * SEQ;
    for (int kk = 0; kk < 128; ++kk) { const int j = (rs + (kk >> 4)) * 64 + cs + (kk & 15); o += ps[w][kk] * bf2f(vp[j]); }
    OC[(size_t)tok * 512 + h * 64 + lane] = f2bf(o);
}
__global__ void __launch_bounds__(256) nv_attn_b(const bf16_t* QB, const bf16_t* KB, const bf16_t* VT, bf16_t* OB, const float* lq1, const float* lk1, const float* lq2, const float* lk2,
                                                 const float* gain, float lam_init) {
    __shared__ float as[4][2048];
    const int w = threadIdx.x >> 6, lane = threadIdx.x & 63;
    const int item = blockIdx.x * 4 + w, tok = item >> 2, h = item & 3, b = tok >> 11, s = tok & 2047;
    const float lam = __expf(wave_sum(lq1[lane] * lk1[lane])) - __expf(wave_sum(lq2[lane] * lk2[lane])) + lam_init;
    const float slope = exp2f(-8.f * (float)(8 + h + 1) / 12.f) * LOG2E;
    float p1[32];
    {
        float q[64]; load_q64(q, QB + (size_t)tok * 512 + h * 128);
        float mx = -INFINITY;
#pragma unroll
        for (int i = 0; i < 32; ++i) { const int j = lane + 64 * i; p1[i] = dot64_bf(q, KB + (size_t)(b * SEQ + j) * 512 + h * 128) - slope * fabsf((float)(j - s)); mx = fmaxf(mx, p1[i]); }
        mx = wave_max(mx); float l = 0.f;
#pragma unroll
        for (int i = 0; i < 32; ++i) { p1[i] = exp2f(p1[i] - mx); l += p1[i]; }
        l = wave_sum(l); const float rl = 1.f / l;
#pragma unroll
        for (int i = 0; i < 32; ++i) p1[i] *= rl;
    }
    {
        float q[64]; load_q64(q, QB + (size_t)tok * 512 + h * 128 + 64);
        float p2[32]; float mx = -INFINITY;
#pragma unroll
        for (int i = 0; i < 32; ++i) { const int j = lane + 64 * i; p2[i] = dot64_bf(q, KB + (size_t)(b * SEQ + j) * 512 + h * 128 + 64) - slope * fabsf((float)(j - s)); mx = fmaxf(mx, p2[i]); }
        mx = wave_max(mx); float l = 0.f;
#pragma unroll
        for (int i = 0; i < 32; ++i) { p2[i] = exp2f(p2[i] - mx); l += p2[i]; }
        l = wave_sum(l); const float rl = lam / l;
#pragma unroll
        for (int i = 0; i < 32; ++i) as[w][lane + 64 * i] = p1[i] - p2[i] * rl;
    }
    __syncthreads();
    float o0 = 0.f, o1 = 0.f;
    const bf16_t* v0 = VT + (size_t)(128 + h * 128 + lane) * NTOK + (size_t)b * SEQ; const bf16_t* v1 = v0 + (size_t)64 * NTOK;
    for (int j8 = 0; j8 < 256; ++j8) {
        const u32x4_t a = *(const u32x4_t*)(v0 + 8 * j8), c = *(const u32x4_t*)(v1 + 8 * j8);
#pragma unroll
        for (int i = 0; i < 4; ++i) {
            const float pa = as[w][8 * j8 + 2 * i], pb = as[w][8 * j8 + 2 * i + 1];
            o0 += pa * __uint_as_float(a[i] << 16) + pb * __uint_as_float(a[i] & 0xffff0000u);
            o1 += pa * __uint_as_float(c[i] << 16) + pb * __uint_as_float(c[i] & 0xffff0000u);
        }
    }
    const float ssq = wave_sum(o0 * o0 + o1 * o1), rr = rsqrtf(ssq * (1.f / 128.f) + LN_EPS) * (1.f - lam_init);
    OB[(size_t)tok * 512 + h * 128 + lane] = f2bf(o0 * rr * gain[lane]);
    OB[(size_t)tok * 512 + h * 128 + 64 + lane] = f2bf(o1 * rr * gain[64 + lane]);
}

DI void ln_row(const float* src, const float* g, const float* bta, float* dstF, bf16_t* dstB, int lane) {
    typedef float f4 __attribute__((ext_vector_type(4)));
    f4 v[4]; float s = 0.f;
#pragma unroll
    for (int j = 0; j < 4; ++j) { v[j] = *(const f4*)(src + 256 * j + 4 * lane); s += (v[j].x + v[j].y) + (v[j].z + v[j].w); }
    const float mean = wave_sum(s) * (1.f / DM); float s2 = 0.f;
#pragma unroll
    for (int j = 0; j < 4; ++j) { v[j] = v[j] - mean; s2 += (v[j].x * v[j].x + v[j].y * v[j].y) + (v[j].z * v[j].z + v[j].w * v[j].w); }
    const float rstd = rsqrtf(wave_sum(s2) * (1.f / DM) + LN_EPS);
#pragma unroll
    for (int j = 0; j < 4; ++j) {
        const f4 gg = *(const f4*)(g + 256 * j + 4 * lane), bb = *(const f4*)(bta + 256 * j + 4 * lane);
        const f4 o = v[j] * rstd * gg + bb;
        *(f4*)(dstF + 256 * j + 4 * lane) = o;
        if (dstB) { uint2 pk; pk.x = (unsigned)f2bf(o.x) | ((unsigned)f2bf(o.y) << 16); pk.y = (unsigned)f2bf(o.z) | ((unsigned)f2bf(o.w) << 16); *(uint2*)(dstB + 256 * j + 4 * lane) = pk; }
    }
}
DI void topk_token(const float* lg, int* ti, float* tw) {
    float v[32];
#pragma unroll
    for (int e = 0; e < 32; ++e) v[e] = lg[e];
    int idx[4]; float val[4];
#pragma unroll
    for (int k = 0; k < 4; ++k) {
        float best = -INFINITY; int bi = 0;
#pragma unroll
        for (int e = 0; e < 32; ++e) { const bool taken = (k > 0 && idx[0] == e) || (k > 1 && idx[1] == e) || (k > 2 && idx[2] == e); if (!taken && v[e] > best) { best = v[e]; bi = e; } }
        idx[k] = bi; val[k] = best;
    }
    float l = 0.f, ex[4];
#pragma unroll
    for (int k = 0; k < 4; ++k) { ex[k] = __expf(val[k] - val[0]); l += ex[k]; }
#pragma unroll
    for (int k = 0; k < 4; ++k) { ti[k] = idx[k]; tw[k] = ex[k] / l; }
}
DI void hist_block(const int* topi, int* hist, int vb, int* lds_hist) {
    if (threadIdx.x < 32) lds_hist[threadIdx.x] = 0;
    __syncthreads();
    for (int a = threadIdx.x; a < 256; a += blockDim.x) atomicAdd(&lds_hist[topi[vb * 256 + a]], 1);
    __syncthreads();
    if (threadIdx.x < 32) hist[vb * 32 + threadIdx.x] = lds_hist[threadIdx.x];
    __syncthreads();
}
DI void dispatch_block(unsigned char* ws, int vb, int* lds) {
    const int* hist = (const int*)(ws + WS_HIST); const int* topi = (const int*)(ws + WS_TOPI); const float* topw = (const float*)(ws + WS_TOPW);
    int* tslot = (int*)(ws + WS_TSLOT); int* rtok = (int*)(ws + WS_RTOK); float* rw = (float*)(ws + WS_RW); int* pane = (int*)(ws + WS_PANE);
    int* cnt = lds, *base = lds + 32, *pstart = lds + 64, *npan = lds + 96;
    if (threadIdx.x < 32) { const int e = threadIdx.x; int c = 0, bsum = 0; for (int b2 = 0; b2 < NRB; ++b2) { const int hv = hist[b2 * 32 + e]; c += hv; if (b2 < vb) bsum += hv; } cnt[e] = c; base[e] = bsum; }
    __syncthreads();
    if (threadIdx.x == 0) { int acc = 0; for (int e = 0; e < 32; ++e) { pstart[e] = acc; acc += ((cnt[e] + 255) >> 8) << 8; } npan[0] = acc >> 8; }
    __syncthreads();
    if (threadIdx.x < 32) {
        const int e = threadIdx.x; int slot = pstart[e] + base[e];
        for (int a = 0; a < 256; ++a) { if (topi[vb * 256 + a] == e) { tslot[vb * 256 + a] = slot; rtok[slot] = vb * 64 + (a >> 2); rw[slot] = topw[vb * 256 + a]; ++slot; } }
        if (vb == 0) { const int p0 = pstart[e] >> 8, p1 = p0 + ((cnt[e] + 255) >> 8); for (int p = p0; p < p1; ++p) pane[p] = e; if (e == 0) pane[511] = npan[0]; }
    }
    __syncthreads();
    const bf16_t* x1b = (const bf16_t*)(ws + WS_X1B); bf16_t* xs = (bf16_t*)(ws + WS_XS);
    for (int i = threadIdx.x; i < 256 * 128; i += blockDim.x) {
        const int a = i >> 7, c = i & 127; const int slot = tslot[vb * 256 + a];
        *(u32x4_t*)(xs + (size_t)slot * DM + 8 * c) = *(const u32x4_t*)(x1b + (size_t)(vb * 64 + (a >> 2)) * DM + 8 * c);
    }
    __syncthreads();
}
DI void combine_row(unsigned char* ws, int tok, const float* g, const float* bta, float* outF, bf16_t* outB, int lane) {
    typedef float f4 __attribute__((ext_vector_type(4)));
    const float* x1 = (const float*)(ws + WS_X1F) + (size_t)tok * DM; const bf16_t* ys = (const bf16_t*)(ws + WS_YS); const int* tslot = (const int*)(ws + WS_TSLOT) + tok * 4;
    f4 v[4]; float s = 0.f;
#pragma unroll
    for (int j = 0; j < 4; ++j) v[j] = *(const f4*)(x1 + 256 * j + 4 * lane) * DN_ALPHA;
#pragma unroll
    for (int k = 0; k < 4; ++k) { const bf16_t* yr = ys + (size_t)tslot[k] * DM;
#pragma unroll
        for (int j = 0; j < 4; ++j) { const uint2 pk = *(const uint2*)(yr + 256 * j + 4 * lane);
            v[j].x += __uint_as_float(pk.x << 16); v[j].y += __uint_as_float(pk.x & 0xffff0000u); v[j].z += __uint_as_float(pk.y << 16); v[j].w += __uint_as_float(pk.y & 0xffff0000u); } }
#pragma unroll
    for (int j = 0; j < 4; ++j) s += (v[j].x + v[j].y) + (v[j].z + v[j].w);
    const float mean = wave_sum(s) * (1.f / DM); float s2 = 0.f;
#pragma unroll
    for (int j = 0; j < 4; ++j) { v[j] = v[j] - mean; s2 += (v[j].x * v[j].x + v[j].y * v[j].y) + (v[j].z * v[j].z + v[j].w * v[j].w); }
    const float rstd = rsqrtf(wave_sum(s2) * (1.f / DM) + LN_EPS);
#pragma unroll
    for (int j = 0; j < 4; ++j) {
        const f4 gg = *(const f4*)(g + 256 * j + 4 * lane), bb = *(const f4*)(bta + 256 * j + 4 * lane);
        const f4 o = v[j] * rstd * gg + bb;
        *(f4*)(outF + (size_t)tok * DM + 256 * j + 4 * lane) = o;
        if (outB) { uint2 pk; pk.x = (unsigned)f2bf(o.x) | ((unsigned)f2bf(o.y) << 16); pk.y = (unsigned)f2bf(o.z) | ((unsigned)f2bf(o.w) << 16); *(uint2*)(outB + (size_t)tok * DM + 256 * j + 4 * lane) = pk; }
    }
}

__global__ void __launch_bounds__(256) k_ln1(const float* Y, const float* g, const float* b, float* X1F, bf16_t* X1B) {
    const int row = blockIdx.x * 4 + (threadIdx.x >> 6); ln_row(Y + (size_t)row * DM, g, b, X1F + (size_t)row * DM, X1B + (size_t)row * DM, threadIdx.x & 63);
}
__global__ void __launch_bounds__(256) k_router_naive(const float* X1F, const float* wr, const float* br, float* logits) {
    const int gid = blockIdx.x * 256 + threadIdx.x, tok = gid >> 5, e = gid & 31; const float* x = X1F + (size_t)tok * DM; float acc = 0.f;
    for (int k = 0; k < DM; ++k) acc += x[k] * wr[k * 32 + e];
    logits[gid] = acc + br[e];
}
__global__ void __launch_bounds__(256) k_topk(const float* logits, int* ti, float* tw) { const int tok = blockIdx.x * 256 + threadIdx.x; topk_token(logits + tok * 32, ti + tok * 4, tw + tok * 4); }
__global__ void __launch_bounds__(256) k_hist(unsigned char* ws) { __shared__ int lh[32]; hist_block((const int*)(ws + WS_TOPI), (int*)(ws + WS_HIST), blockIdx.x, lh); }
__global__ void __launch_bounds__(256) k_dispatch(unsigned char* ws) { __shared__ int l[128]; dispatch_block(ws, blockIdx.x, l); }
__global__ void __launch_bounds__(256) k_combine(unsigned char* ws, const float* g, const float* b, float* outF, bf16_t* outB) {
    const int tok = blockIdx.x * 4 + (threadIdx.x >> 6); combine_row(ws, tok, g, b, outF, outB, threadIdx.x & 63);
}

namespace pg8 {
#define PG8_LAS __attribute__((address_space(3)))
typedef unsigned short bf16_t;
typedef short bf16x8 __attribute__((ext_vector_type(8)));
typedef float f32x4 __attribute__((ext_vector_type(4)));
typedef unsigned u32x4 __attribute__((ext_vector_type(4)));
constexpr int BM = 256, BK = 64, HALF = 128, HTB = HALF * BK * 2  , STAGE_BYTES = 8 * HTB, NXCD = 8, WGM = 8;

__host__ __device__ __forceinline__ int lds_byte(int r, int c) { const int st = (r >> 4) * 2 + (c >> 5), rr = r & 15, cc = c & 31, ob = rr * 64 + cc * 2; return st * 1024 + (ob ^ (((ob >> 9) & 1) << 5)); }
__host__ __device__ __forceinline__ void stage_rc(int b, int& R, int& C) { const int st = b / 1024, sb = b % 1024, swz = sb ^ (((sb >> 9) & 1) << 5); R = (st >> 1) * 16 + swz / 64; C = (st & 1) * 32 + (swz % 64) / 2; }
__host__ __device__ __forceinline__ int perm32(int rho) { const int n = rho >> 4, i = rho & 15; return 8 * (i >> 2) + 4 * n + (i & 3); }

struct Unit { int pm, pn; };
struct Gemm { const bf16_t* A; const bf16_t* Bt; int M, N, K; };

struct StaticOrder {
    int nM, nN, nwg, G, c;
    __host__ __device__ void init(int M, int N, int G_, int c_) { nM = M / BM; nN = N / BM; nwg = nM * nN; G = G_; c = c_; }
    __host__ __device__ bool next(int i, Unit& u) const {
        const long L = (long)i * G + c; if (L >= nwg) return false;
        int wgid = (int)L; { const int q = nwg / NXCD, r = nwg % NXCD, xcd = wgid % NXCD, off = wgid / NXCD; wgid = (xcd < r ? xcd * (q + 1) : r * (q + 1) + (xcd - r) * q) + off; }
        const int nig = WGM * nN, gid = wgid / nig, fm = gid * WGM, gsz = (nM - fm) < WGM ? (nM - fm) : WGM;
        u.pm = fm + ((wgid % nig) % gsz); u.pn = (wgid % nig) / gsz; return true;
    }
    __device__ __forceinline__ void a_ready(const Unit&) const {}
    __device__ __forceinline__ void done(const Unit&) const {}
};
__device__ __forceinline__ unsigned cvt_pk_bf16(float lo, float hi) { unsigned r; asm volatile("v_cvt_pk_bf16_f32 %0, %1, %2" : "=v"(r) : "v"(lo), "v"(hi)); return r; }
typedef float f32x2 __attribute__((ext_vector_type(2)));
template <class Epi, class Sched, bool ALIGN_EPI = false, bool SP2 = false>
__device__ __forceinline__ void gemm_phase(PG8_LAS unsigned char* lds, const Gemm g, const Sched& S, const Epi& E, const int wid_in) {
    unsigned ones_ = ~0u; asm volatile("" : "+s"(ones_)); const int tid = wid_in * 64 + (int)__builtin_amdgcn_mbcnt_hi(ones_, __builtin_amdgcn_mbcnt_lo(ones_, 0u));
    const int wid = __builtin_amdgcn_readfirstlane(tid >> 6), lane = tid & 63, wr = wid >> 2, wc = wid & 3, fr = lane & 15, fq = lane >> 4;
    const int K = g.K, nt = K / BK;
    unsigned voffA[2], voffB[2];
#pragma unroll
    for (int i = 0; i < 2; ++i) { int R, C; stage_rc(tid * 16 + i * 8192, R, C); const int Rb = Epi::PERM ? ((R & ~31) + perm32(R & 31)) : R;
        voffA[i] = (unsigned)(R * K + C) * 2u; voffB[i] = (unsigned)(Rb * K + C) * 2u; }
    const size_t kstep = (size_t)(BK * 2);
    const size_t hstep = (size_t)HALF * K * 2;
    const size_t tstep = 2 * hstep;
    const unsigned ldsw = (unsigned)wid * 1024u;
    const int aoff = lds_byte(wr * 64 + fr, fq * 8), boff = lds_byte(wc * 32 + fr, fq * 8);
#define PG8_SA(b, h) (((b) * 2 + (h)) * HTB)
#define PG8_SB(b, h) ((4 + (b) * 2 + (h)) * HTB)
#define PG8_STAGE(bufoff, gbase, voff) do { _Pragma("unroll") for (int _i = 0; _i < 2; ++_i) \
        __builtin_amdgcn_global_load_lds((const unsigned*)((const char*)(gbase) + (voff)[_i]), (PG8_LAS unsigned*)(lds + (bufoff) + ldsw + _i * 8192), 16, 0, 0); } while (0)
#define PG8_LDA(dst, b, h) do { _Pragma("unroll") for (int m = 0; m < 4; ++m) _Pragma("unroll") for (int k = 0; k < 2; ++k) dst[m][k] = *(const PG8_LAS bf16x8*)(lds + PG8_SA(b, h) + aoff + m * 2048 + k * 1024); } while (0)
#define PG8_LDB(dst, b, h) do { _Pragma("unroll") for (int n = 0; n < 2; ++n) _Pragma("unroll") for (int k = 0; k < 2; ++k) dst[n][k] = *(const PG8_LAS bf16x8*)(lds + PG8_SB(b, h) + boff + n * 2048 + k * 1024); } while (0)
#define PG8_MMA(ai, bj, At, Bt) do { __builtin_amdgcn_s_setprio(1); _Pragma("unroll") for (int m = 0; m < 4; ++m) _Pragma("unroll") for (int n = 0; n < 2; ++n) _Pragma("unroll") for (int k = 0; k < 2; ++k) \
        acc[ai][bj][m][n] = __builtin_amdgcn_mfma_f32_16x16x32_bf16(Bt[n][k], At[m][k], acc[ai][bj][m][n], 0, 0, 0); __builtin_amdgcn_s_setprio(0); } while (0)
#define PG8_WAIT_V(n) asm volatile("s_waitcnt vmcnt(" #n ")" ::: "memory")
#define PG8_WAIT_L(n) asm volatile("s_waitcnt lgkmcnt(" #n ")" ::: "memory")
#define PG8_BAR __builtin_amdgcn_s_barrier()
#define PG8_SCHED __builtin_amdgcn_sched_barrier(0)
    Unit cur, nxt; int ui = 0;
    if (!S.next(0, cur)) return;
    f32x4 acc[2][2][4][2];
#pragma unroll
    for (int a = 0; a < 2; ++a)
#pragma unroll
        for (int b = 0; b < 2; ++b)
#pragma unroll
            for (int m = 0; m < 4; ++m)
#pragma unroll
                for (int n = 0; n < 2; ++n) acc[a][b][m][n] = (f32x4){0.f, 0.f, 0.f, 0.f};
    bf16x8 At[4][2], B0[2][2], B1[2][2];
    const char* cA = (const char*)g.A + (size_t)cur.pm * tstep; const char* cB = (const char*)g.Bt + (size_t)cur.pn * tstep;
    S.a_ready(cur);
    if constexpr (SP2) {
        PG8_STAGE(PG8_SB(0, 0), cB, voffB); PG8_STAGE(PG8_SB(0, 1), cB + hstep, voffB); PG8_STAGE(PG8_SA(0, 0), cA, voffA); PG8_STAGE(PG8_SA(0, 1), cA + hstep, voffA);
        if (wr == 1) PG8_BAR;
        PG8_WAIT_V(2); PG8_BAR;
        PG8_STAGE(PG8_SB(1, 0), cB + kstep, voffB); PG8_STAGE(PG8_SA(1, 0), cA + kstep, voffA); PG8_STAGE(PG8_SB(1, 1), cB + hstep + kstep, voffB);
        PG8_WAIT_V(6); PG8_BAR;
    } else {
        PG8_STAGE(PG8_SB(0, 0), cB, voffB); PG8_STAGE(PG8_SA(0, 0), cA, voffA); PG8_STAGE(PG8_SB(0, 1), cB + hstep, voffB); PG8_STAGE(PG8_SA(0, 1), cA + hstep, voffA);
        if (wr == 1) PG8_BAR;
        PG8_WAIT_V(4); PG8_BAR;
        PG8_STAGE(PG8_SB(1, 0), cB + kstep, voffB); PG8_STAGE(PG8_SA(1, 0), cA + kstep, voffA); PG8_STAGE(PG8_SB(1, 1), cB + hstep + kstep, voffB);
        PG8_WAIT_V(6); PG8_BAR;
    }
    for (;;) {
        const bool has_next = S.next(ui + 1, nxt);
        const char* nA = has_next ? (const char*)g.A + (size_t)nxt.pm * tstep : cA; const char* nB = has_next ? (const char*)g.Bt + (size_t)nxt.pn * tstep : cB;
        for (int t = 0; t < nt; t += 2) {
            const bool last = (t == nt - 2);
            const char* a1 = cA + (size_t)(t + 1) * kstep;
            const char* a2 = last ? nA : cA + (size_t)(t + 2) * kstep; const char* b2 = last ? nB : cB + (size_t)(t + 2) * kstep;
            const char* a3 = a2 + kstep; const char* b3 = b2 + kstep;
            if (last && has_next) S.a_ready(nxt);
            if constexpr (SP2) {
            PG8_LDB(B0, 0, 0); PG8_LDB(B1, 0, 1); PG8_SCHED; PG8_LDA(At, 0, 0); PG8_STAGE(PG8_SA(1, 1), a1 + hstep, voffA);
            PG8_WAIT_V(8); PG8_WAIT_L(0); PG8_BAR; PG8_MMA(0, 0, At, B0); PG8_MMA(0, 1, At, B1); PG8_BAR; PG8_SCHED;
            PG8_LDA(At, 0, 1); PG8_STAGE(PG8_SB(0, 0), b2, voffB); PG8_STAGE(PG8_SB(0, 1), b2 + hstep, voffB); PG8_STAGE(PG8_SA(0, 0), a2, voffA);
            PG8_WAIT_V(8); PG8_WAIT_L(0); PG8_BAR; PG8_MMA(1, 0, At, B0); PG8_MMA(1, 1, At, B1); PG8_BAR; PG8_SCHED;
            PG8_LDB(B0, 1, 0); PG8_LDB(B1, 1, 1); PG8_SCHED; PG8_LDA(At, 1, 0); PG8_STAGE(PG8_SA(0, 1), a2 + hstep, voffA);
            PG8_WAIT_V(8); PG8_WAIT_L(0); PG8_BAR; PG8_MMA(0, 0, At, B0); PG8_MMA(0, 1, At, B1); PG8_BAR; PG8_SCHED;
            PG8_LDA(At, 1, 1); PG8_STAGE(PG8_SB(1, 0), b3, voffB); PG8_STAGE(PG8_SB(1, 1), b3 + hstep, voffB); PG8_STAGE(PG8_SA(1, 0), a3, voffA);
            PG8_WAIT_V(8); PG8_WAIT_L(0); PG8_BAR; PG8_MMA(1, 0, At, B0); PG8_MMA(1, 1, At, B1); PG8_BAR; PG8_SCHED;
            } else {
            PG8_LDB(B0, 0, 0); PG8_SCHED; PG8_LDA(At, 0, 0); PG8_STAGE(PG8_SA(1, 1), a1 + hstep, voffA);
            PG8_WAIT_L(8); PG8_BAR; PG8_WAIT_L(0); PG8_MMA(0, 0, At, B0); PG8_BAR; PG8_SCHED;
            PG8_LDB(B1, 0, 1); PG8_STAGE(PG8_SB(0, 0), b2, voffB);
            PG8_BAR; PG8_WAIT_L(0); PG8_MMA(0, 1, At, B1); PG8_BAR;
            PG8_LDA(At, 0, 1); PG8_STAGE(PG8_SA(0, 0), a2, voffA);
            PG8_BAR; PG8_WAIT_L(0); PG8_MMA(1, 0, At, B0); PG8_BAR; PG8_SCHED;
            PG8_STAGE(PG8_SB(0, 1), b2 + hstep, voffB);
            PG8_WAIT_V(6); PG8_BAR; PG8_MMA(1, 1, At, B1); PG8_BAR;
            PG8_LDB(B0, 1, 0); PG8_SCHED; PG8_LDA(At, 1, 0); PG8_STAGE(PG8_SA(0, 1), a2 + hstep, voffA);
            PG8_WAIT_L(8); PG8_BAR; PG8_WAIT_L(0); PG8_MMA(0, 0, At, B0); PG8_BAR; PG8_SCHED;
            PG8_LDB(B1, 1, 1); PG8_STAGE(PG8_SB(1, 0), b3, voffB);
            PG8_BAR; PG8_WAIT_L(0); PG8_MMA(0, 1, At, B1); PG8_BAR;
            PG8_LDA(At, 1, 1); PG8_STAGE(PG8_SA(1, 0), a3, voffA);
            PG8_BAR; PG8_WAIT_L(0); PG8_MMA(1, 0, At, B0); PG8_BAR; PG8_SCHED;
            PG8_STAGE(PG8_SB(1, 1), b3 + hstep, voffB);
            PG8_WAIT_V(6); PG8_BAR; PG8_MMA(1, 1, At, B1); PG8_BAR;
            }
        }
        if constexpr (ALIGN_EPI) { if (wr == 0) PG8_BAR; }
        if constexpr (!Epi::AFTER_DRAIN) { E(acc, cur, wr, wc, fr, fq); S.done(cur); }
        if (!has_next) break;
#pragma unroll
        for (int a = 0; a < 2; ++a)
#pragma unroll
            for (int b = 0; b < 2; ++b)
#pragma unroll
                for (int m = 0; m < 4; ++m)
#pragma unroll
                    for (int n = 0; n < 2; ++n) acc[a][b][m][n] = (f32x4){0.f, 0.f, 0.f, 0.f};
        cur = nxt; cA = nA; cB = nB; ++ui;
        if constexpr (ALIGN_EPI) { if (wr == 1) PG8_BAR; }
    }
    PG8_WAIT_V(0);
    if constexpr (!ALIGN_EPI) { if (wr == 0) PG8_BAR; }
    PG8_BAR;
    if constexpr (Epi::AFTER_DRAIN) { E.fused(acc, cur, wr, wc, fr, fq, lds, wid, lane); S.done(cur); }
#undef PG8_SA
#undef PG8_SB
#undef PG8_STAGE
#undef PG8_LDA
#undef PG8_LDB
#undef PG8_MMA
#undef PG8_WAIT_V
#undef PG8_WAIT_L
#undef PG8_BAR
#undef PG8_SCHED
}
}

#define GAS __attribute__((address_space(1)))
#define LAS __attribute__((address_space(3)))
typedef GAS unsigned gu32;
typedef GAS unsigned long long gu64;
#define RLX_AGENT __ATOMIC_RELAXED, __HIP_MEMORY_SCOPE_AGENT
#define XB_TMO      128
#define XB_XCNT(j)  (256  + 64 * (j))
#define XB_XSUB(j)  (1280 + 64 * (j))
#define XB_XGEN(j)  (2304 + 64 * (j))
#define XB_TOP      3328
#define XB_TOPGEN   3392
#define XCD_BAR_WORDS 3456
#define XB_SPIN_CAP (1u << 18)

__device__ __forceinline__ unsigned xb_ld(unsigned* p)              { return __hip_atomic_load(p, __ATOMIC_RELAXED, __HIP_MEMORY_SCOPE_AGENT); }
__device__ __forceinline__ unsigned xb_add(unsigned* p, unsigned v) { return __hip_atomic_fetch_add(p, v, __ATOMIC_RELAXED, __HIP_MEMORY_SCOPE_AGENT); }
__device__ __forceinline__ unsigned xb_xcc_id() { return (unsigned)__builtin_amdgcn_s_getreg((3 << 11) | 20) & 0xFu; }
#define XB_SPIN(cond, bar) do { unsigned _sp = 0; while (cond) { __builtin_amdgcn_s_sleep(1); \
    if ((++_sp & 255u) == 0u) { if (xb_ld(&(bar)[XB_TMO])) break; if (_sp > XB_SPIN_CAP) { atomicAdd(&(bar)[XB_TMO], 1u); break; } } } } while (0)

struct XcdBarrier {
    unsigned* bar; unsigned x;
    volatile LAS unsigned* st;
};

__device__ __forceinline__ XcdBarrier xcd_barrier_post(unsigned* bar, volatile LAS unsigned* st) {
    XcdBarrier b; b.bar = bar; b.x = xb_xcc_id(); b.st = st;
    if (threadIdx.x == 0) (void)xb_add(&bar[XB_XCNT(b.x)], 1u);
    return b;
}
__device__ __forceinline__ void xcd_barrier_complete(unsigned* bar, unsigned x, unsigned& nloc, unsigned& nx) {
    const unsigned G = gridDim.x * gridDim.y * gridDim.z;
    unsigned sum, cnt, mine, sp = 0u;
    for (;;) {
        sum = 0u; cnt = 0u; mine = 0u;
#pragma unroll
        for (unsigned j = 0; j < 16; ++j) { const unsigned c = xb_ld(&bar[XB_XCNT(j)]); sum += c; cnt += (c > 0u) ? 1u : 0u; mine = (j == x) ? c : mine; }
        if (sum == G) break;
        __builtin_amdgcn_s_sleep(1);
        if ((++sp & 255u) == 0u) { if (xb_ld(&bar[XB_TMO])) break; if (sp > XB_SPIN_CAP) { atomicAdd(&bar[XB_TMO], 1u); break; } }
    }
    nloc = mine > 0u ? mine : 1u; nx = cnt > 0u ? cnt : 1u;
}

__device__ __forceinline__ void xcd_barrier(const XcdBarrier& b) {
    asm volatile("s_waitcnt vmcnt(0)" ::: "memory");
    __syncthreads();
    if (threadIdx.x == 0) {
        unsigned* bar = b.bar;
        __builtin_amdgcn_s_waitcnt(0);
        unsigned nloc = b.st[0], nx = b.st[1];
        if (nloc == 0u) { xcd_barrier_complete(bar, b.x, nloc, nx); b.st[0] = nloc; b.st[1] = nx; }
        const unsigned old = xb_add(&bar[XB_XSUB(b.x)], 1u);
        const unsigned gen = old / nloc;
        if (old + 1u == (gen + 1u) * nloc) {
            __builtin_amdgcn_fence(__ATOMIC_RELEASE, "agent");
            asm volatile("s_waitcnt vmcnt(0)" ::: "memory");
            const unsigned og = xb_add(&bar[XB_TOP], 1u);
            const unsigned tg = og / nx;
            if (og + 1u == (tg + 1u) * nx) xb_add(&bar[XB_TOPGEN], 1u);
            else XB_SPIN(xb_ld(&bar[XB_TOPGEN]) == tg, bar);
            __builtin_amdgcn_fence(__ATOMIC_ACQUIRE, "agent");
            xb_add(&bar[XB_XGEN(b.x)], 1u);
            asm volatile("s_waitcnt vmcnt(0)" ::: "memory");
        } else {
            XB_SPIN(xb_ld(&bar[XB_XGEN(b.x)]) == gen, bar);
            __builtin_amdgcn_fence(__ATOMIC_ACQUIRE, "agent");
            asm volatile("s_waitcnt vmcnt(0)" ::: "memory");
        }
    }
    __syncthreads();
}

typedef short bf16x8 __attribute__((ext_vector_type(8)));
typedef float f32x16 __attribute__((ext_vector_type(16)));
typedef float f32x4 __attribute__((ext_vector_type(4)));
#define MFMA32(a, b, c) __builtin_amdgcn_mfma_f32_32x32x16_bf16((a), (b), (c), 0, 0, 0)

constexpr int NWAVES = 8, NTHREADS = 512;
constexpr int LDS_GEMM = 131072;
constexpr int LDS_MISC = LDS_GEMM;
constexpr int LDS_BYTES = 147456;
constexpr int CW_BAR = 4096;
constexpr int NPHASE = 19;

struct MArgs { const float* in[21]; float* out; unsigned char* ws; int ph_lo, ph_hi; };

DI unsigned pk2bf(float lo, float hi) { return pg8::cvt_pk_bf16(lo, hi); }
DI float fast_sigmoid(float x) { return __builtin_amdgcn_rcpf(1.f + __builtin_amdgcn_exp2f(-LOG2E * x)); }

constexpr int TP_PITCH = 72;
DI void transpose_item(const float* W, int K, int N, int k0, int n0, bf16_t* dst  , LAS bf16_t* T, int lane) {
    const int kr = lane >> 4, nc = lane & 15;
#pragma unroll 4
    for (int it = 0; it < 16; ++it) {
        const f32x4 v = *(const f32x4*)(W + (size_t)(k0 + 4 * it + kr) * N + n0 + 4 * nc);
        const int k = 4 * it + kr;
        T[(4 * nc + 0) * TP_PITCH + k] = f2bf(v.x); T[(4 * nc + 1) * TP_PITCH + k] = f2bf(v.y); T[(4 * nc + 2) * TP_PITCH + k] = f2bf(v.z); T[(4 * nc + 3) * TP_PITCH + k] = f2bf(v.w);
    }
    asm volatile("s_waitcnt lgkmcnt(0)" ::: "memory");
    const int nr = lane >> 3, kc = lane & 7;
#pragma unroll
    for (int it = 0; it < 8; ++it) {
        const int n = 8 * it + nr;
        const u32x4_t o = *(const LAS u32x4_t*)(T + n * TP_PITCH + 8 * kc);
        *(u32x4_t*)(dst + (size_t)n * K + k0 + 8 * kc) = o;
    }
    asm volatile("s_waitcnt lgkmcnt(0)" ::: "memory");
}
DI int win_row(int n0) {
    if (n0 < 512) return n0;
    if (n0 < 640) return 5632 + (n0 - 512);
    if (n0 < 768) return 5888 + (n0 - 640);
    if (n0 < 1280) return 512 + (n0 - 768);
    if (n0 < 1792) return 1024 + (n0 - 1280);
    if (n0 < 2304) return 5888 + 128 + (n0 - 1792);
    if (n0 < 2816) return 1536 + (n0 - 2304);
    if (n0 < 3328) return 2048 + (n0 - 2816);
    if (n0 < 3840) return 5888 + 640 + (n0 - 3328);
    return 2560 + (n0 - 3840);
}
DI void prologue_phase(const MArgs& A, LAS unsigned char* lds, int gw, int ngw, int wave, int lane) {
    LAS bf16_t* T = (LAS bf16_t*)(lds + wave * 16384);
    constexpr int I_IN = 16 * 108, I_OUT = 16 * 16, I_BR = 3 * 8 * 16, I_UP = 32 * 16 * 32, I_DN = 32 * 16 * 16, I_L = I_IN + I_OUT + I_BR + I_UP + I_DN;
    for (int it = gw; it < 2 * I_L; it += ngw) {
        const int l = it / I_L; int r = it % I_L;
        unsigned char* wl = A.ws + WS_W + (size_t)l * WL_BYTES;
        if (r < I_IN) { const int kb = r / 108, nb = r % 108; const float* W = A.in[1] + (size_t)l * DM * IN_W;
            transpose_item(W, DM, IN_W, 64 * kb, 64 * nb, (bf16_t*)(wl + WL_IN) + (size_t)win_row(64 * nb) * DM, T, lane); continue; }
        r -= I_IN;
        if (r < I_OUT) { const int kb = r / 16, nb = r % 16; const float* W = A.in[10] + (size_t)l * DM * DM;
            transpose_item(W, DM, DM, 64 * kb, 64 * nb, (bf16_t*)(wl + WL_OUT) + (size_t)(64 * nb) * DM, T, lane); continue; }
        r -= I_OUT;
        if (r < I_BR) { const int i = r / 128, q = r % 128, kb = q / 16, nb = q % 16; const float* W = A.in[9] + ((size_t)l * 3 + i) * 512 * DM;
            transpose_item(W, 512, DM, 64 * kb, 64 * nb, (bf16_t*)(wl + WL_BR) + (size_t)(i * 1024 + 64 * nb) * 512, T, lane); continue; }
        r -= I_BR;
        if (r < I_UP) { const int e = r / 512, q = r % 512, kb = q / 32, nb = q % 32; const float* W = A.in[15] + ((size_t)l * NE + e) * DM * 2048;
            const int n0 = 64 * nb, nn = n0 & 1023, row = (nn >> 7) * 256 + (n0 >= 1024 ? 128 : 0) + (nn & 127);
            transpose_item(W, DM, 2048, 64 * kb, n0, (bf16_t*)(wl + WL_UP) + (size_t)(e * 2048 + row) * DM, T, lane); continue; }
        r -= I_UP;
        { const int e = r / 256, q = r % 256, kb = q / 16, nb = q % 16; const float* W = A.in[17] + ((size_t)l * NE + e) * FE * DM;
            transpose_item(W, FE, DM, 64 * kb, 64 * nb, (bf16_t*)(wl + WL_DN) + (size_t)(e * 1024 + 64 * nb) * FE, T, lane); }
    }
    for (int m = gw; m < NTOK; m += ngw) {
        const float* xr = A.in[0] + (size_t)m * DM; bf16_t* o = (bf16_t*)(A.ws + WS_XB) + (size_t)m * DM;
#pragma unroll
        for (int j = 0; j < 4; ++j) { const f32x4 v = *(const f32x4*)(xr + 256 * j + 4 * lane); uint2 pk; pk.x = pk2bf(v.x, v.y); pk.y = pk2bf(v.z, v.w); *(uint2*)(o + 256 * j + 4 * lane) = pk; }
    }
}

struct SchedInProj {
    pg8::StaticOrder so; int xb0, w0;
    DI bool next(int i, pg8::Unit& u) const { pg8::Unit v; if (!so.next(i, v)) return false;
        if (v.pn < 23) { u.pm = xb0 + v.pm; u.pn = w0 + v.pn; } else { u.pm = w0 + v.pn; u.pn = xb0 + v.pm; } return true; }
    DI void a_ready(const pg8::Unit&) const {}
    DI void done(const pg8::Unit&) const {}
};
struct SchedBranch {
    int c, G, a0, b0;
    DI bool next(int i, pg8::Unit& u) const { const int p = c + (i / 3) * G; if (p >= 256) return false; const int br = i % 3; u.pm = a0 + br * 64 + (p >> 2); u.pn = b0 + br * 4 + (p & 3); return true; }
    DI void a_ready(const pg8::Unit&) const {}
    DI void done(const pg8::Unit&) const {}
};
struct SchedPlain {
    pg8::StaticOrder so; int a0, b0;
    DI bool next(int i, pg8::Unit& u) const { pg8::Unit v; if (!so.next(i, v)) return false; u.pm = a0 + v.pm; u.pn = b0 + v.pn; return true; }
    DI void a_ready(const pg8::Unit&) const {}
    DI void done(const pg8::Unit&) const {}
};
struct SchedMoe {
    const int* pane; int NJ, a0, b0, G, c, nunits;
    DI bool next(int i, pg8::Unit& u) const {
        const long L = (long)i * G + c; if (L >= nunits) return false;
        int id = (int)L; { const int q = nunits / 8, r = nunits % 8, x = id % 8, off = id / 8; id = (x < r ? x * (q + 1) : r * (q + 1) + (x - r) * q) + off; }
        const int p = id / NJ, j = id % NJ; const int e = __builtin_amdgcn_readfirstlane(pane[p]);
        u.pm = a0 + p; u.pn = b0 + e * NJ + j; return true; }
    DI void a_ready(const pg8::Unit&) const {}
    DI void done(const pg8::Unit&) const {}
};

struct EpiInProj {
    static constexpr bool PERM = true, AFTER_DRAIN = false;
    unsigned char* ws; int xb0, w0;
    DI void operator()(const f32x4 (&acc)[2][2][4][2], const pg8::Unit& u, int wr, int wc, int fr, int fq) const {
        const int r0 = wr * 64 + fr, c0 = wc * 32 + 8 * fq;
        if (u.pm >= xb0) {
            const int t = u.pn - w0, tok0 = (u.pm - xb0) * 256;
            bf16_t* base; int ld, colb; float sc = 1.f; bool sig = false; int nbj = 2;
            if (t < 2) { base = (bf16_t*)(ws + WS_QA); ld = 512; colb = 256 * t; sc = C2; }
            else if (t < 4) { base = (bf16_t*)(ws + WS_QB); ld = 512; colb = 256 * (t - 2); sc = C2; }
            else if (t < 6) { base = (bf16_t*)(ws + WS_KB); ld = 512; colb = 256 * (t - 4); }
            else if (t < 8) { base = (bf16_t*)(ws + WS_QC); ld = 512; colb = 256 * (t - 6); sc = C2; }
            else if (t < 10) { base = (bf16_t*)(ws + WS_KC); ld = 512; colb = 256 * (t - 8); }
            else if (t < 22) { base = (bf16_t*)(ws + WS_G); ld = 3072; colb = 256 * (t - 10); sig = true; }
            else { base = (bf16_t*)(ws + WS_KA); ld = 128; colb = 0; nbj = 1; }
#pragma unroll
            for (int ai = 0; ai < 2; ++ai)
#pragma unroll
                for (int m = 0; m < 4; ++m) { bf16_t* rowp = base + (size_t)(tok0 + r0 + ai * 128 + m * 16) * ld + colb + c0;
#pragma unroll
                    for (int bj = 0; bj < 2; ++bj) { if (bj < nbj) { f32x4 v0 = acc[ai][bj][m][0] * sc, v1 = acc[ai][bj][m][1] * sc;
                        if (sig) { v0 = (f32x4){fast_sigmoid(v0.x), fast_sigmoid(v0.y), fast_sigmoid(v0.z), fast_sigmoid(v0.w)}; v1 = (f32x4){fast_sigmoid(v1.x), fast_sigmoid(v1.y), fast_sigmoid(v1.z), fast_sigmoid(v1.w)}; }
                        u32x4_t w; w.x = pk2bf(v0.x, v0.y); w.y = pk2bf(v0.z, v0.w); w.z = pk2bf(v1.x, v1.y); w.w = pk2bf(v1.z, v1.w);
                        *(u32x4_t*)(rowp + bj * 128) = w; } } }
        } else {
            const int ch0 = (u.pm - w0 - 23) * 256, tok0 = (u.pn - xb0) * 256; bf16_t* VT = (bf16_t*)(ws + WS_VT);
#pragma unroll
            for (int ai = 0; ai < 2; ++ai)
#pragma unroll
                for (int m = 0; m < 4; ++m) { bf16_t* rowp = VT + (size_t)(ch0 + r0 + ai * 128 + m * 16) * NTOK + tok0 + c0;
#pragma unroll
                    for (int bj = 0; bj < 2; ++bj) { const f32x4 v0 = acc[ai][bj][m][0], v1 = acc[ai][bj][m][1];
                        u32x4_t w; w.x = pk2bf(v0.x, v0.y); w.y = pk2bf(v0.z, v0.w); w.z = pk2bf(v1.x, v1.y); w.w = pk2bf(v1.z, v1.w);
                        *(u32x4_t*)(rowp + bj * 128) = w; } }
        }
    }
};
struct EpiBranch {
    static constexpr bool PERM = true, AFTER_DRAIN = false;
    unsigned char* ws; int a0, b0;
    DI void operator()(const f32x4 (&acc)[2][2][4][2], const pg8::Unit& u, int wr, int wc, int fr, int fq) const {
        const int i = (u.pn - b0) >> 2, pn = (u.pn - b0) & 3, pm = (u.pm - a0) & 63;
        const bf16_t* G = (const bf16_t*)(ws + WS_G); bf16_t* MB = (bf16_t*)(ws + WS_MB);
        const int r0 = pm * 256 + wr * 64 + fr, c0 = pn * 256 + wc * 32 + 8 * fq;
#pragma unroll
        for (int ai = 0; ai < 2; ++ai)
#pragma unroll
            for (int m = 0; m < 4; ++m) { const size_t row = (size_t)(r0 + ai * 128 + m * 16);
#pragma unroll
                for (int bj = 0; bj < 2; ++bj) { const int col = c0 + bj * 128;
                    const u32x4_t gw = *(const u32x4_t*)(G + row * 3072 + i * 1024 + col);
                    f32x4 v0, v1;
                    v0.x = __uint_as_float(gw.x << 16) * acc[ai][bj][m][0].x; v0.y = __uint_as_float(gw.x & 0xffff0000u) * acc[ai][bj][m][0].y;
                    v0.z = __uint_as_float(gw.y << 16) * acc[ai][bj][m][0].z; v0.w = __uint_as_float(gw.y & 0xffff0000u) * acc[ai][bj][m][0].w;
                    v1.x = __uint_as_float(gw.z << 16) * acc[ai][bj][m][1].x; v1.y = __uint_as_float(gw.z & 0xffff0000u) * acc[ai][bj][m][1].y;
                    v1.z = __uint_as_float(gw.w << 16) * acc[ai][bj][m][1].z; v1.w = __uint_as_float(gw.w & 0xffff0000u) * acc[ai][bj][m][1].w;
                    bf16_t* mp = MB + row * DM + col;
                    if (i > 0) { const u32x4_t pw = *(const u32x4_t*)mp;
                        v0.x += __uint_as_float(pw.x << 16); v0.y += __uint_as_float(pw.x & 0xffff0000u); v0.z += __uint_as_float(pw.y << 16); v0.w += __uint_as_float(pw.y & 0xffff0000u);
                        v1.x += __uint_as_float(pw.z << 16); v1.y += __uint_as_float(pw.z & 0xffff0000u); v1.z += __uint_as_float(pw.w << 16); v1.w += __uint_as_float(pw.w & 0xffff0000u); }
                    u32x4_t w; w.x = pk2bf(v0.x, v0.y); w.y = pk2bf(v0.z, v0.w); w.z = pk2bf(v1.x, v1.y); w.w = pk2bf(v1.z, v1.w); *(u32x4_t*)mp = w; } }
    }
};
struct EpiWout {
    static constexpr bool PERM = false, AFTER_DRAIN = false;
    const float* x; float* Y; int a0, b0;
    DI void operator()(const f32x4 (&acc)[2][2][4][2], const pg8::Unit& u, int wr, int wc, int fr, int fq) const {
        const int r0 = (u.pm - a0) * 256 + wr * 64 + fr, c0 = (u.pn - b0) * 256 + wc * 32 + 4 * fq;
#pragma unroll
        for (int ai = 0; ai < 2; ++ai)
#pragma unroll
            for (int m = 0; m < 4; ++m) { const size_t ro = (size_t)(r0 + ai * 128 + m * 16) * DM + c0;
#pragma unroll
                for (int bj = 0; bj < 2; ++bj)
#pragma unroll
                    for (int n = 0; n < 2; ++n) { const size_t o = ro + bj * 128 + n * 16; *(f32x4*)(Y + o) = *(const f32x4*)(x + o) * DN_ALPHA + acc[ai][bj][m][n]; } }
    }
};
struct EpiUp {
    static constexpr bool PERM = true, AFTER_DRAIN = false;
    unsigned char* ws; const float* b_up; int a0, b0;
    DI void operator()(const f32x4 (&acc)[2][2][4][2], const pg8::Unit& u, int wr, int wc, int fr, int fq) const {
        const int t = u.pn - b0, e = t >> 3, j = t & 7; bf16_t* ACT = (bf16_t*)(ws + WS_ACTB);
        const int r0 = (u.pm - a0) * 256 + wr * 64 + fr, c0 = j * 128 + wc * 32 + 8 * fq;
        f32x4 bg[2], bl[2];
#pragma unroll
        for (int n = 0; n < 2; ++n) { bg[n] = *(const f32x4*)(b_up + e * 2048 + c0 + 4 * n); bl[n] = *(const f32x4*)(b_up + e * 2048 + 1024 + c0 + 4 * n) + 1.f; }
#pragma unroll
        for (int ai = 0; ai < 2; ++ai)
#pragma unroll
            for (int m = 0; m < 4; ++m) { float o[8];
#pragma unroll
                for (int n = 0; n < 2; ++n)
#pragma unroll
                    for (int q = 0; q < 4; ++q) { float hg = acc[ai][0][m][n][q] + bg[n][q], hl = acc[ai][1][m][n][q] + bl[n][q];
                        hg = fminf(hg, SWI_LIMIT); hl = fminf(fmaxf(hl, 1.f - SWI_LIMIT), 1.f + SWI_LIMIT);
                        o[4 * n + q] = hg * fast_sigmoid(SWI_ALPHA * hg) * hl; }
                u32x4_t w; w.x = pk2bf(o[0], o[1]); w.y = pk2bf(o[2], o[3]); w.z = pk2bf(o[4], o[5]); w.w = pk2bf(o[6], o[7]);
                *(u32x4_t*)(ACT + (size_t)(r0 + ai * 128 + m * 16) * FE + c0) = w; }
    }
};
struct EpiDown {
    static constexpr bool PERM = true, AFTER_DRAIN = false;
    unsigned char* ws; const float* b_dn; int a0, b0;
    DI void operator()(const f32x4 (&acc)[2][2][4][2], const pg8::Unit& u, int wr, int wc, int fr, int fq) const {
        const int t = u.pn - b0, e = t >> 2, j = t & 3; bf16_t* YS = (bf16_t*)(ws + WS_YS); const float* rw = (const float*)(ws + WS_RW);
        const int r0 = (u.pm - a0) * 256 + wr * 64 + fr, c0 = j * 256 + wc * 32 + 8 * fq;
        f32x4 bv[2][2];
#pragma unroll
        for (int bj = 0; bj < 2; ++bj)
#pragma unroll
            for (int n = 0; n < 2; ++n) bv[bj][n] = *(const f32x4*)(b_dn + e * DM + c0 + bj * 128 + 4 * n);
#pragma unroll
        for (int ai = 0; ai < 2; ++ai)
#pragma unroll
            for (int m = 0; m < 4; ++m) { const int row = r0 + ai * 128 + m * 16; const float w8 = rw[row];
#pragma unroll
                for (int bj = 0; bj < 2; ++bj) { const f32x4 v0 = (acc[ai][bj][m][0] + bv[bj][0]) * w8, v1 = (acc[ai][bj][m][1] + bv[bj][1]) * w8;
                    u32x4_t w; w.x = pk2bf(v0.x, v0.y); w.y = pk2bf(v0.z, v0.w); w.z = pk2bf(v1.x, v1.y); w.w = pk2bf(v1.z, v1.w);
                    *(u32x4_t*)(YS + (size_t)row * DM + c0 + bj * 128) = w; } }
    }
};

DI int kperm(int r) { return (r & 16) + 8 * ((r >> 2) & 1) + 4 * ((r >> 3) & 1) + (r & 3); }
DI float half_max(float v) { auto rr = __builtin_amdgcn_permlane32_swap(__float_as_uint(v), __float_as_uint(v), false, false); return fmaxf(__uint_as_float(rr[0]), __uint_as_float(rr[1])); }
DI float half_sum(float v) { auto rr = __builtin_amdgcn_permlane32_swap(__float_as_uint(v), __float_as_uint(v), false, false); return __uint_as_float(rr[0]) + __uint_as_float(rr[1]); }
constexpr float ATT_THR = 8.f;
struct SoftState { float m, l; };
DI bf16x8 pack8(const f32x16& s, int st) {
    u32x4_t p; p.x = pk2bf(s[8 * st + 0], s[8 * st + 1]); p.y = pk2bf(s[8 * st + 2], s[8 * st + 3]); p.z = pk2bf(s[8 * st + 4], s[8 * st + 5]); p.w = pk2bf(s[8 * st + 6], s[8 * st + 7]);
    return __builtin_bit_cast(bf16x8, p);
}
DI f32x16 qk_tile(const bf16_t* krow  , const bf16x8 (&qf)[4]) {
    f32x16 s = {0.f, 0.f, 0.f, 0.f, 0.f, 0.f, 0.f, 0.f, 0.f, 0.f, 0.f, 0.f, 0.f, 0.f, 0.f, 0.f};
#pragma unroll
    for (int st = 0; st < 4; ++st) { const bf16x8 kf = *(const bf16x8*)(krow + 16 * st); s = MFMA32(kf, qf[st], s); }
    return s;
}
template <int NB> DI void soft_tile(f32x16& s, SoftState& st, f32x16 (&o)[NB]) {
    float mx = s[0];
#pragma unroll
    for (int r = 1; r < 16; ++r) mx = fmaxf(mx, s[r]);
    mx = half_max(mx);
    if (__any(mx > st.m + ATT_THR)) {
        const float mn = fmaxf(st.m, mx), f = __builtin_amdgcn_exp2f(st.m - mn);
        st.m = mn; st.l *= f;
#pragma unroll
        for (int b = 0; b < NB; ++b)
#pragma unroll
            for (int r = 0; r < 16; ++r) o[b][r] *= f;
    }
    float sum = 0.f;
#pragma unroll
    for (int r = 0; r < 16; ++r) { s[r] = __builtin_amdgcn_exp2f(s[r] - st.m); sum += s[r]; }
    st.l += sum;
}
DI void load_qf(bf16x8 (&qf)[4], const bf16_t* qrow  ) {
#pragma unroll
    for (int st = 0; st < 4; ++st) qf[st] = *(const bf16x8*)(qrow + 16 * st);
}
template <int NB> DI void zero_o(f32x16 (&o)[NB]) {
#pragma unroll
    for (int b = 0; b < NB; ++b)
#pragma unroll
        for (int r = 0; r < 16; ++r) o[b][r] = 0.f;
}
template <int NB> DI void pv_tile(f32x16 (&o)[NB], const bf16_t* vt, const bf16x8& p0, const bf16x8& p1) {
#pragma unroll
    for (int b = 0; b < NB; ++b) {
        const bf16x8 v0 = *(const bf16x8*)(vt + (size_t)(32 * b) * NTOK), v1 = *(const bf16x8*)(vt + (size_t)(32 * b) * NTOK + 16);
        o[b] = MFMA32(v0, p0, o[b]); o[b] = MFMA32(v1, p1, o[b]);
    }
}
template <int NB> DI void store_o(const f32x16 (&o)[NB], bf16_t* orow  , int h) {
#pragma unroll
    for (int b = 0; b < NB; ++b)
#pragma unroll
        for (int g = 0; g < 4; ++g) { uint2 pk; pk.x = pk2bf(o[b][4 * g], o[b][4 * g + 1]); pk.y = pk2bf(o[b][4 * g + 2], o[b][4 * g + 3]); *(uint2*)(orow + 32 * b + 8 * g + 4 * h) = pk; }
}

DI void attn_a_task(const MArgs& A, int l, int task, int lane) {
    asm volatile("" : "+v"(lane));
    const int r = lane & 31, h = lane >> 5; const int qt = task & 63, hd = (task >> 6) & 7, b = task >> 9, g = hd >> 2;
    const int q0 = qt * 32, qpos = q0 + r; const size_t tb = (size_t)b * SEQ;
    const bf16_t* QA = (const bf16_t*)(A.ws + WS_QA); const bf16_t* KA = (const bf16_t*)(A.ws + WS_KA); const bf16_t* VT = (const bf16_t*)(A.ws + WS_VT);
    bf16x8 qf[4]; load_qf(qf, QA + (tb + qpos) * 512 + hd * 64 + 8 * h);
    const float slope = exp2f(-8.f * (float)(hd + 1) / 12.f) * LOG2E, sk = A.in[2][l * 8 + hd] * LOG2E;
    f32x16 o[2]; zero_o<2>(o); SoftState st{-1e30f, 0.f};
    const int kp = kperm(r);
    for (int t = 0; t < 9; ++t) {
        const int k0 = q0 - 128 + 32 * t; if (k0 < 0 || k0 >= SEQ) continue;
        f32x16 s = qk_tile(KA + (tb + k0 + kp) * 128 + g * 64 + 8 * h, qf);
#pragma unroll
        for (int reg = 0; reg < 16; ++reg) { const int kpos = k0 + 16 * (reg >> 3) + 8 * h + (reg & 7); const int d = kpos - qpos; const int ad = d < 0 ? -d : d;
            s[reg] = ad <= 128 ? s[reg] - slope * (float)ad : -INFINITY; }
        soft_tile<2>(s, st, o);
        pv_tile<2>(o, VT + (size_t)(g * 64 + r) * NTOK + tb + k0 + 8 * h, pack8(s, 0), pack8(s, 1));
    }
    float lsum = half_sum(st.l); lsum += __builtin_amdgcn_exp2f(sk - st.m);
    const float rl = 1.f / lsum;
#pragma unroll
    for (int bb = 0; bb < 2; ++bb)
#pragma unroll
        for (int reg = 0; reg < 16; ++reg) o[bb][reg] *= rl;
    store_o<2>(o, (bf16_t*)(A.ws + WS_BR) + (tb + qpos) * 512 + hd * 64, h);
}
DI void attn_c_task(const MArgs& A, int l, int task, int lane, LAS float* tbl  ) {
    asm volatile("" : "+v"(lane));
    const int r = lane & 31, h = lane >> 5; const int j = task & 3, rp = (task >> 2) & 15, hd = (task >> 6) & 7, b = task >> 9;
    const int qrow = 2 * rp + (r >> 4), qc = 16 * j + (r & 15), qpos = qrow * 64 + qc; const size_t tb = (size_t)b * SEQ;
    const int c0 = j == 0 ? 0 : (j == 1 ? 8 : (j == 2 ? 24 : 32));
    const int rsq = min(max(qrow - 4, 0), 24), cs = min(max(qc - 8, 0), 48), lo = cs - c0;
    const int rs0 = min(max(2 * rp - 4, 0), 24), rs1 = min(max(2 * rp - 3, 0), 24);
    const bf16_t* QC = (const bf16_t*)(A.ws + WS_QC); const bf16_t* KC = (const bf16_t*)(A.ws + WS_KC); const bf16_t* VT = (const bf16_t*)(A.ws + WS_VT);
    const float* rpb = A.in[8] + ((size_t)l * 8 + hd) * 15 * 31;
#pragma unroll
    for (int k = 0; k < 8; ++k) { const int i = lane + 64 * k; if (i < 465) tbl[128 + i] = rpb[i] * LOG2E; }
    bf16x8 qf[4]; load_qf(qf, QC + (tb + qpos) * 512 + hd * 64 + 8 * h);
    f32x16 o[2]; zero_o<2>(o); SoftState st{-1e30f, 0.f};
    const int kp = kperm(r);
    for (int kr = rs0; kr < rs1 + 8; ++kr) {
        const int k0 = kr * 64 + c0;
        f32x16 s = qk_tile(KC + (tb + k0 + kp) * 512 + hd * 64 + 8 * h, qf);
        const bool rowok = kr >= rsq && kr < rsq + 8;
        const LAS float* bp = tbl + 128 + (kr - qrow + 7) * 31 + (c0 - qc + 15) + 8 * h;
#pragma unroll
        for (int reg = 0; reg < 16; ++reg) { const int ko = 16 * (reg >> 3) + (reg & 7); const int kof = ko + 8 * h; const bool ok = rowok && kof >= lo && kof < lo + 16;
            const float bias = bp[ko]; s[reg] = ok ? s[reg] + bias : -INFINITY; }
        soft_tile<2>(s, st, o);
        pv_tile<2>(o, VT + (size_t)(640 + hd * 64 + r) * NTOK + tb + k0 + 8 * h, pack8(s, 0), pack8(s, 1));
    }
    const float l_ = half_sum(st.l); const float rl = 1.f / l_;
#pragma unroll
    for (int bb = 0; bb < 2; ++bb)
#pragma unroll
        for (int reg = 0; reg < 16; ++reg) o[bb][reg] *= rl;
    store_o<2>(o, (bf16_t*)(A.ws + WS_BR) + (size_t)2 * NTOK * 512 + (tb + qpos) * 512 + hd * 64, h);
}
DI void attn_b_task(const MArgs& A, int l, int task, int lane) {
    asm volatile("" : "+v"(lane));
    const int r = lane & 31, h = lane >> 5; const int qt = task & 63, hd = (task >> 6) & 3, b = task >> 8;
    const int q0 = qt * 32, qpos = q0 + r; const size_t tb = (size_t)b * SEQ;
    const bf16_t* QB = (const bf16_t*)(A.ws + WS_QB); const bf16_t* KB = (const bf16_t*)(A.ws + WS_KB); const bf16_t* VT = (const bf16_t*)(A.ws + WS_VT);
    const float lam_init = 0.8f - 0.6f * __expf(-0.3f * (float)l);
    const float lam = __expf(wave_sum(A.in[3][l * 64 + lane] * A.in[4][l * 64 + lane])) - __expf(wave_sum(A.in[5][l * 64 + lane] * A.in[6][l * 64 + lane])) + lam_init;
    const float slope = exp2f(-8.f * (float)(8 + hd + 1) / 12.f) * LOG2E;
    bf16x8 q1[4], q2[4]; load_qf(q1, QB + (tb + qpos) * 512 + hd * 128 + 8 * h); load_qf(q2, QB + (tb + qpos) * 512 + hd * 128 + 64 + 8 * h);
    f32x16 o1[4], o2[4]; zero_o<4>(o1); zero_o<4>(o2); SoftState s1{-1e30f, 0.f}, s2{-1e30f, 0.f};
    const int kp = kperm(r);
    const bf16_t* kbase = KB + (tb + kp) * 512 + hd * 128 + 8 * h; const bf16_t* vbase = VT + (size_t)(128 + hd * 128 + r) * NTOK + tb + 8 * h;
    for (int t = 0; t < 64; ++t) {
        const int k0 = 32 * t; const float dbase = (float)(k0 + 8 * h - qpos);
        f32x16 sa = qk_tile(kbase + (size_t)k0 * 512, q1);
#pragma unroll
        for (int reg = 0; reg < 16; ++reg) sa[reg] -= slope * fabsf(dbase + (float)(16 * (reg >> 3) + (reg & 7)));
        soft_tile<4>(sa, s1, o1);
        const bf16x8 pa0 = pack8(sa, 0), pa1 = pack8(sa, 1);
        f32x16 sb = qk_tile(kbase + (size_t)k0 * 512 + 64, q2);
#pragma unroll
        for (int reg = 0; reg < 16; ++reg) sb[reg] -= slope * fabsf(dbase + (float)(16 * (reg >> 3) + (reg & 7)));
        soft_tile<4>(sb, s2, o2);
        const bf16x8 pb0 = pack8(sb, 0), pb1 = pack8(sb, 1);
#pragma unroll
        for (int bb = 0; bb < 4; ++bb) {
            const bf16x8 v0 = *(const bf16x8*)(vbase + (size_t)(32 * bb) * NTOK + k0), v1 = *(const bf16x8*)(vbase + (size_t)(32 * bb) * NTOK + k0 + 16);
            o1[bb] = MFMA32(v0, pa0, o1[bb]); o1[bb] = MFMA32(v1, pa1, o1[bb]);
            o2[bb] = MFMA32(v0, pb0, o2[bb]); o2[bb] = MFMA32(v1, pb1, o2[bb]);
        }
    }
    const float r1 = 1.f / (s1.l + __shfl_xor(s1.l, 32)), r2 = lam / (s2.l + __shfl_xor(s2.l, 32));
    float ssq = 0.f;
#pragma unroll
    for (int bb = 0; bb < 4; ++bb)
#pragma unroll
        for (int reg = 0; reg < 16; ++reg) { const float v = o1[bb][reg] * r1 - o2[bb][reg] * r2; o1[bb][reg] = v; ssq += v * v; }
    ssq += __shfl_xor(ssq, 32);
    const float rr = rsqrtf(ssq * (1.f / 128.f) + LN_EPS) * (1.f - lam_init);
    const float* gain = A.in[7] + l * 128;
#pragma unroll
    for (int bb = 0; bb < 4; ++bb)
#pragma unroll
        for (int g4 = 0; g4 < 4; ++g4) { const f32x4 gv = *(const f32x4*)(gain + 32 * bb + 8 * g4 + 4 * h);
            o1[bb][4 * g4] *= rr * gv.x; o1[bb][4 * g4 + 1] *= rr * gv.y; o1[bb][4 * g4 + 2] *= rr * gv.z; o1[bb][4 * g4 + 3] *= rr * gv.w; }
    store_o<4>(o1, (bf16_t*)(A.ws + WS_BR) + (size_t)NTOK * 512 + (tb + qpos) * 512 + hd * 128, h);
}

#define XORC(a, CSTR) ({ int r_; asm volatile("v_xor_b32_e32 %0, " CSTR ", %1" : "=v"(r_) : "v"(a)); r_; })
constexpr int AB_KBUF = 0, AB_VBUF = 32768, AB_BUFSZ = 16384;
DI void attn_b_unit(const MArgs& A, int l, int unit, LAS unsigned char* lds, int wave, int lane) {
    const int r = lane & 31, h = lane >> 5; const int qb = unit & 7, hd = (unit >> 3) & 3, b = unit >> 5;
    const int q0 = qb * 256 + wave * 32, qpos = q0 + r; const size_t tb = (size_t)b * SEQ;
    const bf16_t* QB = (const bf16_t*)(A.ws + WS_QB); const bf16_t* KB = (const bf16_t*)(A.ws + WS_KB); const bf16_t* VT = (const bf16_t*)(A.ws + WS_VT);
    const float slope = exp2f(-8.f * (float)(8 + hd + 1) / 12.f) * LOG2E;
    bf16x8 q1[4], q2[4]; load_qf(q1, QB + (tb + qpos) * 512 + hd * 128 + 8 * h); load_qf(q2, QB + (tb + qpos) * 512 + hd * 128 + 64 + 8 * h);
    f32x16 o1[4], o2[4]; zero_o<4>(o1); zero_o<4>(o2); SoftState s1{-1e30f, 0.f}, s2{-1e30f, 0.f};
    const int p0 = wave * 64 + lane, rw0 = p0 >> 4, cs = (p0 & 15) ^ (rw0 & 15);
    const unsigned offK = (unsigned)(rw0 * 512 + 8 * cs) * 2u;
    const unsigned offV = (unsigned)((2 * rw0 + (cs >> 3)) * NTOK + 8 * (cs & 7)) * 2u;
    const unsigned char* kbase_u = (const unsigned char*)(KB + tb * 512 + hd * 128);
    const unsigned char* vbase_u = (const unsigned char*)(VT + (size_t)(128 + hd * 128) * NTOK + tb);
    const int dstoff = wave * 1024;
#define AB_DMA(stage, buf) do { const unsigned char* k_ = kbase_u + (size_t)(stage) * 64 * 512 * 2; const unsigned char* v_ = vbase_u + (stage) * 64 * 2; \
        __builtin_amdgcn_global_load_lds((const unsigned*)(k_ + offK), (LAS unsigned*)(lds + AB_KBUF + (buf) * AB_BUFSZ + dstoff), 16, 0, 0); \
        __builtin_amdgcn_global_load_lds((const unsigned*)(k_ + 32 * 512 * 2 + offK), (LAS unsigned*)(lds + AB_KBUF + (buf) * AB_BUFSZ + dstoff + 8192), 16, 0, 0); \
        __builtin_amdgcn_global_load_lds((const unsigned*)(v_ + offV), (LAS unsigned*)(lds + AB_VBUF + (buf) * AB_BUFSZ + dstoff), 16, 0, 0); \
        __builtin_amdgcn_global_load_lds((const unsigned*)(v_ + (size_t)64 * NTOK * 2 + offV), (LAS unsigned*)(lds + AB_VBUF + (buf) * AB_BUFSZ + dstoff + 8192), 16, 0, 0); } while (0)
    const int key0 = kperm(r);
    const int kaddr = AB_KBUF + key0 * 256 + (((h ^ key0) & 15) << 4);
    const int pr0 = r >> 1;
    const int vaddr = AB_VBUF + pr0 * 256 + ((((8 * (r & 1) + h) ^ pr0) & 15) << 4);
    AB_DMA(0, 0);
    asm volatile("s_waitcnt vmcnt(0)" ::: "memory"); __syncthreads();
    for (int stg = 0; stg < 32; ++stg) {
        const int buf = stg & 1;
        if (stg + 1 < 32) { if (buf) AB_DMA(stg + 1, 0); else AB_DMA(stg + 1, 1); }
        const int kb_ = kaddr + buf * AB_BUFSZ, vb_ = vaddr + buf * AB_BUFSZ;
#define AB_KRD(CSTR, SUB) (*(const LAS bf16x8*)(lds + (XORC(kb_, CSTR) + (SUB) * 8192)))
#define AB_VRD(CSTR, BB) (*(const LAS bf16x8*)(lds + (XORC(vb_, CSTR) + (BB) * 4096)))
#define AB_SUB(SUB, VC0, VC1) do { \
            const float dbase = (float)(stg * 64 + (SUB) * 32 + 8 * h - qpos); \
            f32x16 sa = {0.f, 0.f, 0.f, 0.f, 0.f, 0.f, 0.f, 0.f, 0.f, 0.f, 0.f, 0.f, 0.f, 0.f, 0.f, 0.f}; \
            sa = MFMA32(AB_KRD("0x00", SUB), q1[0], sa); sa = MFMA32(AB_KRD("0x20", SUB), q1[1], sa); sa = MFMA32(AB_KRD("0x40", SUB), q1[2], sa); sa = MFMA32(AB_KRD("0x60", SUB), q1[3], sa); \
            _Pragma("unroll") for (int reg = 0; reg < 16; ++reg) sa[reg] -= slope * fabsf(dbase + (float)(16 * (reg >> 3) + (reg & 7))); \
            __builtin_amdgcn_sched_barrier(0); soft_tile<4>(sa, s1, o1); \
            const bf16x8 pa0 = pack8(sa, 0), pa1 = pack8(sa, 1); __builtin_amdgcn_sched_barrier(0); \
            f32x16 sb = {0.f, 0.f, 0.f, 0.f, 0.f, 0.f, 0.f, 0.f, 0.f, 0.f, 0.f, 0.f, 0.f, 0.f, 0.f, 0.f}; \
            sb = MFMA32(AB_KRD("0x80", SUB), q2[0], sb); sb = MFMA32(AB_KRD("0xa0", SUB), q2[1], sb); sb = MFMA32(AB_KRD("0xc0", SUB), q2[2], sb); sb = MFMA32(AB_KRD("0xe0", SUB), q2[3], sb); \
            _Pragma("unroll") for (int reg = 0; reg < 16; ++reg) sb[reg] -= slope * fabsf(dbase + (float)(16 * (reg >> 3) + (reg & 7))); \
            __builtin_amdgcn_sched_barrier(0); soft_tile<4>(sb, s2, o2); \
            const bf16x8 pb0 = pack8(sb, 0), pb1 = pack8(sb, 1); __builtin_amdgcn_sched_barrier(0); \
            _Pragma("unroll") for (int bb = 0; bb < 4; ++bb) { \
                const bf16x8 v0 = AB_VRD(VC0, bb), v1 = AB_VRD(VC1, bb); \
                o1[bb] = MFMA32(v0, pa0, o1[bb]); o1[bb] = MFMA32(v1, pa1, o1[bb]); \
                o2[bb] = MFMA32(v0, pb0, o2[bb]); o2[bb] = MFMA32(v1, pb1, o2[bb]); if (bb & 1) __builtin_amdgcn_sched_barrier(0); } } while (0)
        AB_SUB(0, "0x00", "0x20");
        AB_SUB(1, "0x40", "0x60");
#undef AB_SUB
#undef AB_KRD
#undef AB_VRD
        asm volatile("s_waitcnt vmcnt(0)" ::: "memory"); __syncthreads();
    }
#undef AB_DMA
    unsigned ones2 = ~0u; asm volatile("" : "+s"(ones2)); const int lane2 = (int)__builtin_amdgcn_mbcnt_hi(ones2, __builtin_amdgcn_mbcnt_lo(ones2, 0u));
    const int r_ = lane2 & 31, h_ = lane2 >> 5;
    const float lam_init = 0.8f - 0.6f * __expf(-0.3f * (float)l);
    float d1 = 0.f, d2 = 0.f;
#pragma unroll 8
    for (int i = 0; i < 64; ++i) { d1 += A.in[3][l * 64 + i] * A.in[4][l * 64 + i]; d2 += A.in[5][l * 64 + i] * A.in[6][l * 64 + i]; }
    const float lam = __expf(d1) - __expf(d2) + lam_init;
    const float r1 = 1.f / half_sum(s1.l), r2 = lam / half_sum(s2.l);
    float ssq = 0.f;
#pragma unroll
    for (int bb = 0; bb < 4; ++bb)
#pragma unroll
        for (int reg = 0; reg < 16; ++reg) { const float v = o1[bb][reg] * r1 - o2[bb][reg] * r2; o1[bb][reg] = v; ssq += v * v; }
    ssq = half_sum(ssq);
    const float rr = rsqrtf(ssq * (1.f / 128.f) + LN_EPS) * (1.f - lam_init);
    const float* gain = A.in[7] + l * 128;
#pragma unroll
    for (int bb = 0; bb < 4; ++bb)
#pragma unroll
        for (int g4 = 0; g4 < 4; ++g4) { const f32x4 gv = *(const f32x4*)(gain + 32 * bb + 8 * g4 + 4 * h_);
            o1[bb][4 * g4] *= rr * gv.x; o1[bb][4 * g4 + 1] *= rr * gv.y; o1[bb][4 * g4 + 2] *= rr * gv.z; o1[bb][4 * g4 + 3] *= rr * gv.w; }
    store_o<4>(o1, (bf16_t*)(A.ws + WS_BR) + (size_t)NTOK * 512 + (tb + qb * 256 + wave * 32 + r_) * 512 + hd * 128, h_);
}

DI void router_block(const MArgs& A, int l, int vb, LAS unsigned char* lds, int tid, int wave, int lane) {
    const float* Y = (const float*)(A.ws + WS_Y); float* X1F = (float*)(A.ws + WS_X1F); bf16_t* X1B = (bf16_t*)(A.ws + WS_X1B);
    {
        const float* g = A.in[11] + l * DM; const float* bt = A.in[12] + l * DM;
#pragma unroll 1
        for (int k0 = 0; k0 < 8; k0 += 4) {
            f32x4 v[4][4];
#pragma unroll
            for (int k = 0; k < 4; ++k)
#pragma unroll
                for (int j = 0; j < 4; ++j) v[k][j] = *(const f32x4*)(Y + (size_t)(vb * 64 + wave + 8 * (k0 + k)) * DM + 256 * j + 4 * lane);
#pragma unroll
            for (int k = 0; k < 4; ++k) {
                const size_t row = (size_t)(vb * 64 + wave + 8 * (k0 + k)); float sm = 0.f;
#pragma unroll
                for (int j = 0; j < 4; ++j) sm += (v[k][j].x + v[k][j].y) + (v[k][j].z + v[k][j].w);
                const float mean = wave_sum(sm) * (1.f / DM); float s2 = 0.f;
#pragma unroll
                for (int j = 0; j < 4; ++j) { v[k][j] = v[k][j] - mean; s2 += (v[k][j].x * v[k][j].x + v[k][j].y * v[k][j].y) + (v[k][j].z * v[k][j].z + v[k][j].w * v[k][j].w); }
                const float rstd = rsqrtf(wave_sum(s2) * (1.f / DM) + LN_EPS);
#pragma unroll
                for (int j = 0; j < 4; ++j) { const f32x4 gg = *(const f32x4*)(g + 256 * j + 4 * lane), bb = *(const f32x4*)(bt + 256 * j + 4 * lane); const f32x4 o = v[k][j] * rstd * gg + bb;
                    *(f32x4*)(X1F + row * DM + 256 * j + 4 * lane) = o; uint2 pk; pk.x = pk2bf(o.x, o.y); pk.y = pk2bf(o.z, o.w); *(uint2*)(X1B + row * DM + 256 * j + 4 * lane) = pk; }
            }
        }
    }
    __syncthreads();
    LAS float* part = (LAS float*)lds;
    LAS int* lh = (LAS int*)(lds + 16384);
    if (tid < 32) lh[tid] = 0;
    {
        const int tg = wave & 3, kh = wave >> 2, i = lane & 15, kq = lane >> 4;
        const float* xr = X1F + (size_t)(vb * 64 + tg * 16 + i) * DM + kh * 512 + 4 * kq;
        const float* wr = A.in[13] + (size_t)l * DM * 32 + (size_t)(kh * 512 + 4 * kq) * 32 + i;
        f32x4 acc0 = {0.f, 0.f, 0.f, 0.f}, acc1 = {0.f, 0.f, 0.f, 0.f};
#pragma unroll 4
        for (int gk = 0; gk < 32; ++gk) {
            const f32x4 a4 = *(const f32x4*)(xr + 16 * gk);
#pragma unroll
            for (int u = 0; u < 4; ++u) { const float b0 = wr[(16 * gk + u) * 32], b1 = wr[(16 * gk + u) * 32 + 16];
                acc0 = __builtin_amdgcn_mfma_f32_16x16x4f32(a4[u], b0, acc0, 0, 0, 0); acc1 = __builtin_amdgcn_mfma_f32_16x16x4f32(a4[u], b1, acc1, 0, 0, 0); }
        }
#pragma unroll
        for (int reg = 0; reg < 4; ++reg) { const int tk = tg * 16 + 4 * kq + reg; part[(kh * 64 + tk) * 32 + i] = acc0[reg]; part[(kh * 64 + tk) * 32 + 16 + i] = acc1[reg]; }
    }
    __syncthreads();
    if (tid < 64) {
        float lg[32]; const float* br = A.in[14] + l * 32;
#pragma unroll
        for (int e = 0; e < 32; ++e) lg[e] = part[tid * 32 + e] + part[(64 + tid) * 32 + e] + br[e];
        int idx[4]; float val[4];
#pragma unroll
        for (int k = 0; k < 4; ++k) { float best = -INFINITY; int bi = 0;
#pragma unroll
            for (int e = 0; e < 32; ++e) { const bool taken = (k > 0 && idx[0] == e) || (k > 1 && idx[1] == e) || (k > 2 && idx[2] == e); if (!taken && lg[e] > best) { best = lg[e]; bi = e; } }
            idx[k] = bi; val[k] = best; }
        float ls = 0.f, ex[4];
#pragma unroll
        for (int k = 0; k < 4; ++k) { ex[k] = __expf(val[k] - val[0]); ls += ex[k]; }
        int* ti = (int*)(A.ws + WS_TOPI) + (vb * 64 + tid) * 4; float* tw = (float*)(A.ws + WS_TOPW) + (vb * 64 + tid) * 4;
#pragma unroll
        for (int k = 0; k < 4; ++k) { ti[k] = idx[k]; tw[k] = ex[k] / ls; __hip_atomic_fetch_add(&lh[idx[k]], 1, __ATOMIC_RELAXED, __HIP_MEMORY_SCOPE_WORKGROUP); }
    }
    __syncthreads();
    if (tid < 32) ((int*)(A.ws + WS_HIST))[vb * 32 + tid] = lh[tid];
    __syncthreads();
}
DI void dispatch_fast(unsigned char* ws, int vb, LAS int* L, int tid, int nthr) {
    const int* hist = (const int*)(ws + WS_HIST); const int* topi = (const int*)(ws + WS_TOPI); const float* topw = (const float*)(ws + WS_TOPW);
    int* tslot = (int*)(ws + WS_TSLOT); int* rtok = (int*)(ws + WS_RTOK); float* rw = (float*)(ws + WS_RW); int* pane = (int*)(ws + WS_PANE);
    LAS int* pc = L; LAS int* pb = L + 512; LAS int* cnt = L + 1024; LAS int* base = L + 1056; LAS int* pstart = L + 1088; LAS int* npan = L + 1120;
    LAS int* sidx = L + 1152; LAS float* sw = (LAS float*)(L + 1408); LAS int* sslot = L + 1664;
    { const int e = tid & 31, ch = tid >> 5, nch = nthr >> 5; int c = 0, bs = 0;
        for (int b2 = ch; b2 < NRB; b2 += nch) { const int hv = hist[b2 * 32 + e]; c += hv; if (b2 < vb) bs += hv; }
        pc[ch * 32 + e] = c; pb[ch * 32 + e] = bs; }
    if (tid < 256) { sidx[tid] = topi[vb * 256 + tid]; sw[tid] = topw[vb * 256 + tid]; }
    __syncthreads();
    if (tid < 32) { const int nch = nthr >> 5; int c = 0, bs = 0; for (int ch = 0; ch < nch; ++ch) { c += pc[ch * 32 + tid]; bs += pb[ch * 32 + tid]; } cnt[tid] = c; base[tid] = bs; }
    __syncthreads();
    if (tid == 0) { int acc = 0; for (int e = 0; e < 32; ++e) { pstart[e] = acc; acc += ((cnt[e] + 255) >> 8) << 8; } npan[0] = acc >> 8; }
    __syncthreads();
    if (tid < 32) {
        const int e = tid; int slot = pstart[e] + base[e];
        for (int a = 0; a < 256; ++a) { if (sidx[a] == e) { sslot[a] = slot; rtok[slot] = vb * 64 + (a >> 2); rw[slot] = sw[a]; ++slot; } }
        if (vb == 0) { const int p0 = pstart[e] >> 8, p1 = p0 + ((cnt[e] + 255) >> 8); for (int p = p0; p < p1; ++p) pane[p] = e; if (e == 0) pane[511] = npan[0]; }
    }
    __syncthreads();
    if (tid < 256) tslot[vb * 256 + tid] = sslot[tid];
    const bf16_t* x1b = (const bf16_t*)(ws + WS_X1B); bf16_t* xs = (bf16_t*)(ws + WS_XS);
    { const int wv = tid >> 6, ln = tid & 63, nw = nthr >> 6;
        for (int t = wv; t < 64; t += 2 * nw) {
            const int t2 = t + nw; const bool has2 = t2 < 64;
            const bf16_t* s0 = x1b + (size_t)(vb * 64 + t) * DM + 8 * ln; const bf16_t* s1 = x1b + (size_t)(vb * 64 + (has2 ? t2 : t)) * DM + 8 * ln;
            const u32x4_t a0 = *(const u32x4_t*)s0, a1 = *(const u32x4_t*)(s0 + 512), b0 = *(const u32x4_t*)s1, b1 = *(const u32x4_t*)(s1 + 512);
#pragma unroll
            for (int k = 0; k < 4; ++k) { bf16_t* d = xs + (size_t)sslot[4 * t + k] * DM + 8 * ln; *(u32x4_t*)d = a0; *(u32x4_t*)(d + 512) = a1; }
            if (has2) {
#pragma unroll
                for (int k = 0; k < 4; ++k) { bf16_t* d = xs + (size_t)sslot[4 * t2 + k] * DM + 8 * ln; *(u32x4_t*)d = b0; *(u32x4_t*)(d + 512) = b1; } }
        } }
    __syncthreads();
}

typedef const __attribute__((address_space(4))) MArgs* kargs_ptr;
DI MArgs load_margs(kargs_ptr p) { MArgs a;
#pragma unroll
    for (int i = 0; i < 21; ++i) a.in[i] = p->in[i];
    a.out = p->out; a.ws = p->ws; a.ph_lo = p->ph_lo; a.ph_hi = p->ph_hi; return a; }
#define PHASE_ARGS() kargs_ptr ap_ = (kargs_ptr)__builtin_amdgcn_kernarg_segment_ptr(); asm volatile("" : "+s"(ap_)); const MArgs A = load_margs(ap_); \
    int gw = gw0, vcu = vcu0, bx = bx0, wave = wave0; asm volatile("" : "+s"(gw), "+s"(vcu), "+s"(bx), "+s"(wave)); \
    unsigned ones_ = ~0u; asm volatile("" : "+s"(ones_)); int lane = (int)__builtin_amdgcn_mbcnt_hi(ones_, __builtin_amdgcn_mbcnt_lo(ones_, 0u)); int tid = wave * 64 + lane
__global__ void __launch_bounds__(NTHREADS, 2) mega(MArgs A_unused) {
    extern __shared__ __attribute__((aligned(16))) unsigned char lds_raw[];
    LAS unsigned char* lds = (LAS unsigned char*)lds_raw;
    const int tid0 = threadIdx.x, lane0 = tid0 & 63, wave0 = __builtin_amdgcn_readfirstlane(tid0 >> 6);
    const int G = gridDim.x, bx0 = blockIdx.x, vcu0 = (G % 8 == 0) ? (bx0 % 8) * (G / 8) + bx0 / 8 : bx0;
    const int gw0 = vcu0 * NWAVES + wave0, ngw = G * NWAVES;
    volatile LAS unsigned* misc = (volatile LAS unsigned*)(lds + LDS_MISC);
    if (tid0 < 64) misc[tid0] = 0u;
    __syncthreads();
    int lo, hi; XcdBarrier bar;
    { PHASE_ARGS(); (void)gw; (void)vcu; (void)bx; (void)tid; (void)lane; (void)wave; lo = A.ph_lo; hi = A.ph_hi; bar = xcd_barrier_post((unsigned*)(A.ws + WS_CTL) + CW_BAR, misc + 8); }
#define IN(k) (lo <= (k) && (k) < hi)
#define SEAM(k) do { if (IN(k) && IN((k) + 1)) xcd_barrier(bar); } while (0)
    if (IN(0)) { PHASE_ARGS(); prologue_phase(A, lds, gw, ngw, wave, lane); }
    SEAM(0);
    if ((PROBE_REP & 512) && IN(0)) { PHASE_ARGS(); prologue_phase(A, lds, gw, ngw, wave, lane); xcd_barrier(bar); }
    for (int l = 0; l < 2; ++l) {
        const int pb = 1 + 9 * l;
        for (int rep = 0; rep < (((PROBE_REP >> 0) & 1) ? 2 : 1); ++rep)
        if (IN(pb + 0)) {
            PHASE_ARGS(); const pg8::Gemm gm{(const bf16_t*)A.ws, (const bf16_t*)A.ws, 0, 0, DM};
            const int xb0 = (int)(WS_XB >> 19), w0 = (int)((WS_W + (size_t)l * WL_BYTES + WL_IN) >> 19);
            SchedInProj S; S.so.init(NTOK, 28 * 256, G, bx); S.xb0 = xb0; S.w0 = w0;
            EpiInProj E{A.ws, xb0, w0};
            pg8::gemm_phase<EpiInProj, SchedInProj, true, true>(lds, gm, S, E, wave);
        }
        SEAM(pb + 0);
        for (int rep = 0; rep < (((PROBE_REP >> 1) & 1) ? 2 : 1); ++rep)
        if (IN(pb + 1)) {
            PHASE_ARGS();
            if (vcu < 256) attn_b_unit(A, l, vcu, lds, wave, lane);
            if ((PROBE_REP & 1024) && vcu < 256) attn_b_unit(A, l, vcu, lds, wave, lane);
            for (int t = gw; t < 4096; t += ngw) attn_a_task(A, l, t, lane);
            if (PROBE_REP & 2048) for (int t = gw; t < 4096; t += ngw) attn_a_task(A, l, t, lane);
            for (int t = gw; t < 4096; t += ngw) attn_c_task(A, l, t, lane, (LAS float*)(lds + wave * 4096));
            if (PROBE_REP & 4096) for (int t = gw; t < 4096; t += ngw) attn_c_task(A, l, t, lane, (LAS float*)(lds + wave * 4096));
        }
        SEAM(pb + 1);
        for (int rep = 0; rep < (((PROBE_REP >> 2) & 1) ? 2 : 1); ++rep)
        if (IN(pb + 2)) {
            PHASE_ARGS(); const pg8::Gemm gm512{(const bf16_t*)A.ws, (const bf16_t*)A.ws, 0, 0, 512};
            const int a0 = (int)(WS_BR >> 18), b0 = (int)((WS_W + (size_t)l * WL_BYTES + WL_BR) >> 18);
            SchedBranch S{vcu, G, a0, b0};
            EpiBranch E{A.ws, a0, b0};
            pg8::gemm_phase<EpiBranch, SchedBranch, false, true>(lds, gm512, S, E, wave);
        }
        SEAM(pb + 2);
        for (int rep = 0; rep < (((PROBE_REP >> 3) & 1) ? 2 : 1); ++rep)
        if (IN(pb + 3)) {
            PHASE_ARGS(); const pg8::Gemm gm{(const bf16_t*)A.ws, (const bf16_t*)A.ws, 0, 0, DM};
            const float* xcur = l == 0 ? A.in[0] : (const float*)(A.ws + WS_XF);
            const int a0 = (int)(WS_MB >> 19), b0 = (int)((WS_W + (size_t)l * WL_BYTES + WL_OUT) >> 19);
            SchedPlain S; S.so.init(NTOK, DM, G, bx); S.a0 = a0; S.b0 = b0;
            EpiWout E{xcur, (float*)(A.ws + WS_Y), a0, b0};
            pg8::gemm_phase<EpiWout, SchedPlain, false, true>(lds, gm, S, E, wave);
        }
        SEAM(pb + 3);
        for (int rep = 0; rep < (((PROBE_REP >> 4) & 1) ? 2 : 1); ++rep)
        if (IN(pb + 4)) { PHASE_ARGS(); for (int vb = vcu; vb < NRB; vb += G) router_block(A, l, vb, lds, tid, wave, lane); }
        SEAM(pb + 4);
        for (int rep = 0; rep < (((PROBE_REP >> 5) & 1) ? 2 : 1); ++rep)
        if (IN(pb + 5)) { PHASE_ARGS(); for (int vb = vcu; vb < NRB; vb += G) dispatch_fast(A.ws, vb, (LAS int*)lds, tid, NTHREADS); }
        SEAM(pb + 5);
        for (int rep = 0; rep < (((PROBE_REP >> 6) & 1) ? 2 : 1); ++rep)
        if (IN(pb + 6)) {
            PHASE_ARGS(); const pg8::Gemm gm{(const bf16_t*)A.ws, (const bf16_t*)A.ws, 0, 0, DM};
            const int* pane = (const int*)(A.ws + WS_PANE); const int np = __builtin_amdgcn_readfirstlane(pane[511]);
            const int a0 = (int)(WS_XS >> 19), b0 = (int)((WS_W + (size_t)l * WL_BYTES + WL_UP) >> 19);
            SchedMoe S{pane, 8, a0, b0, G, bx, np * 8};
            EpiUp E{A.ws, A.in[16] + (size_t)l * NE * 2048, a0, b0};
            pg8::gemm_phase<EpiUp, SchedMoe, true, true>(lds, gm, S, E, wave);
        }
        SEAM(pb + 6);
        for (int rep = 0; rep < (((PROBE_REP >> 7) & 1) ? 2 : 1); ++rep)
        if (IN(pb + 7)) {
            PHASE_ARGS(); const pg8::Gemm gm{(const bf16_t*)A.ws, (const bf16_t*)A.ws, 0, 0, DM};
            const int* pane = (const int*)(A.ws + WS_PANE); const int np = __builtin_amdgcn_readfirstlane(pane[511]);
            const int a0 = (int)(WS_ACTB >> 19), b0 = (int)((WS_W + (size_t)l * WL_BYTES + WL_DN) >> 19);
            SchedMoe S{pane, 4, a0, b0, G, bx, np * 4};
            EpiDown E{A.ws, A.in[18] + (size_t)l * NE * DM, a0, b0};
            pg8::gemm_phase<EpiDown, SchedMoe, true, true>(lds, gm, S, E, wave);
        }
        SEAM(pb + 7);
        for (int rep = 0; rep < (((PROBE_REP >> 8) & 1) ? 2 : 1); ++rep)
        if (IN(pb + 8)) {
            PHASE_ARGS();
            float* outF = l == 0 ? (float*)(A.ws + WS_XF) : A.out; bf16_t* outB = l == 0 ? (bf16_t*)(A.ws + WS_XB) : nullptr;
            for (int tok = gw; tok < NTOK; tok += ngw) combine_row(A.ws, tok, A.in[19] + l * DM, A.in[20] + l * DM, outF, outB, lane);
        }
        SEAM(pb + 8);
    }
#undef IN
#undef SEAM
}

#ifndef FASTMASK
#define FASTMASK 0x1FF
#endif
#ifndef ONE_LAUNCH
#define ONE_LAUNCH 1
#endif
static void launch_mega(const MArgs& a0, int lo, int hi, hipStream_t stream) {
    MArgs a = a0; a.ph_lo = lo; a.ph_hi = hi;
    hipLaunchKernelGGL(mega, dim3(256), dim3(NTHREADS), LDS_BYTES, stream, a);
}
extern "C" void kernel_launch(void* const* d_in, const int* in_sizes, int n_in, void* d_out, int out_size, void* d_ws, size_t ws_size, hipStream_t stream) {
    if (n_in != 21 || ws_size < WS_END) { fprintf(stderr, "kernel_launch: unexpected inputs (n_in %d, ws %zu)\n", n_in, ws_size); return; }
    static int ready = 0;
    if (!ready) { if (hipFuncSetAttribute((const void*)mega, hipFuncAttributeMaxDynamicSharedMemorySize, LDS_BYTES) != hipSuccess) { fprintf(stderr, "hipFuncSetAttribute failed\n"); } ready = 1; }
    unsigned char* ws = (unsigned char*)d_ws;
    const float* x_in = (const float*)d_in[0];
    (void)hipMemsetAsync(ws + WS_CTL, 0, 1 * MiB, stream);
    MArgs ma{};
    for (int i = 0; i < 21; ++i) ma.in[i] = (const float*)d_in[i];
    ma.out = (float*)d_out; ma.ws = ws;
    if (ONE_LAUNCH) { launch_mega(ma, 0, NPHASE, stream); return; }
    const unsigned fm = FASTMASK;
    if (fm) launch_mega(ma, 0, 1, stream);
    for (int l = 0; l < 2; ++l) {
        const int pb = 1 + 9 * l;
        const float* xcur = l == 0 ? x_in : (const float*)(ws + WS_XF);
        float* xnext = l == 0 ? (float*)(ws + WS_XF) : (float*)d_out;
        const float* w_in = (const float*)d_in[1] + (size_t)l * DM * IN_W;
        const float* a_sink = (const float*)d_in[2] + l * 8;
        const float* lq1 = (const float*)d_in[3] + l * 64; const float* lk1 = (const float*)d_in[4] + l * 64;
        const float* lq2 = (const float*)d_in[5] + l * 64; const float* lk2 = (const float*)d_in[6] + l * 64;
        const float* dng = (const float*)d_in[7] + l * 128;
        const float* rpb = (const float*)d_in[8] + (size_t)l * 8 * 15 * 31;
        const float* w_br = (const float*)d_in[9] + (size_t)l * 3 * 512 * DM;
        const float* w_out = (const float*)d_in[10] + (size_t)l * DM * DM;
        const float* ln1g = (const float*)d_in[11] + l * DM; const float* ln1b = (const float*)d_in[12] + l * DM;
        const float* w_r = (const float*)d_in[13] + (size_t)l * DM * 32; const float* b_r = (const float*)d_in[14] + l * 32;
        const float* w_up = (const float*)d_in[15] + (size_t)l * NE * DM * 2048; const float* b_up = (const float*)d_in[16] + (size_t)l * NE * 2048;
        const float* w_dn = (const float*)d_in[17] + (size_t)l * NE * FE * DM; const float* b_dn = (const float*)d_in[18] + (size_t)l * NE * DM;
        const float* ln2g = (const float*)d_in[19] + l * DM; const float* ln2b = (const float*)d_in[20] + l * DM;
        const float lam_init = 0.8f - 0.6f * expf(-0.3f * (float)l);
        if (fm & 1) launch_mega(ma, pb + 0, pb + 1, stream);
        else nv_gemm<AF32, BKN, EInProj, 1><<<dim3(IN_W / 64, NTOK / 64), 256, 0, stream>>>(AF32{xcur, DM}, BKN{w_in, IN_W, 0}, EInProj{ws}, nullptr, NTOK, IN_W, DM, 0);
        if (fm & 2) launch_mega(ma, pb + 1, pb + 2, stream);
        else {
            nv_attn_a<<<NTOK * 8 / 4, 256, 0, stream>>>((const bf16_t*)(ws + WS_QA), (const bf16_t*)(ws + WS_KA), (const bf16_t*)(ws + WS_VT), (bf16_t*)(ws + WS_BR), a_sink);
            nv_attn_b<<<NTOK * 4 / 4, 256, 0, stream>>>((const bf16_t*)(ws + WS_QB), (const bf16_t*)(ws + WS_KB), (const bf16_t*)(ws + WS_VT), (bf16_t*)(ws + WS_BR) + (size_t)NTOK * 512, lq1, lk1, lq2, lk2, dng, lam_init);
            nv_attn_c<<<NTOK * 8 / 4, 256, 0, stream>>>((const bf16_t*)(ws + WS_QC), (const bf16_t*)(ws + WS_KC), (const bf16_t*)(ws + WS_VT), (bf16_t*)(ws + WS_BR) + (size_t)2 * NTOK * 512, rpb);
        }
        if (fm & 4) launch_mega(ma, pb + 2, pb + 3, stream);
        else for (int i = 0; i < 3; ++i)
            nv_gemm<ABF, BKN, EBranch, 1><<<dim3(DM / 64, NTOK / 64), 256, 0, stream>>>(ABF{(const bf16_t*)(ws + WS_BR) + (size_t)i * NTOK * 512, 512}, BKN{w_br + (size_t)i * 512 * DM, DM, 0}, EBranch{ws, i}, nullptr, NTOK, DM, 512, 0);
        if (fm & 8) launch_mega(ma, pb + 3, pb + 4, stream);
        else nv_gemm<AF32, BKN, EWout, 1><<<dim3(DM / 64, NTOK / 64), 256, 0, stream>>>(AF32{(const float*)(ws + WS_MF), DM}, BKN{w_out, DM, 0}, EWout{xcur, (float*)(ws + WS_Y)}, nullptr, NTOK, DM, DM, 0);
        if (fm & 16) launch_mega(ma, pb + 4, pb + 5, stream);
        else {
            k_ln1<<<NTOK / 4, 256, 0, stream>>>((const float*)(ws + WS_Y), ln1g, ln1b, (float*)(ws + WS_X1F), (bf16_t*)(ws + WS_X1B));
            k_router_naive<<<NTOK * 32 / 256, 256, 0, stream>>>((const float*)(ws + WS_X1F), w_r, b_r, (float*)(ws + WS_LOGIT));
            k_topk<<<NTOK / 256, 256, 0, stream>>>((const float*)(ws + WS_LOGIT), (int*)(ws + WS_TOPI), (float*)(ws + WS_TOPW));
            k_hist<<<NRB, 256, 0, stream>>>(ws);
        }
        (void)hipMemsetAsync(ws + WS_RTOK, 0xFF, NPADROWS * 4, stream);
        if (fm & 32) launch_mega(ma, pb + 5, pb + 6, stream);
        else k_dispatch<<<NRB, 256, 0, stream>>>(ws);
        if (fm & 64) launch_mega(ma, pb + 6, pb + 7, stream);
        else nv_gemm<AGather, BExp, EUp, 2><<<dim3(FE / 64, NPADROWS / 64), 256, 0, stream>>>(AGather{(const float*)(ws + WS_X1F), (const int*)(ws + WS_RTOK)},
            BExp{w_up, (const int*)(ws + WS_PANE), (size_t)DM * 2048, 2048, 1024}, EUp{b_up, (const int*)(ws + WS_PANE), (bf16_t*)(ws + WS_ACTB)}, (const int*)(ws + WS_PANE) + 511, NPADROWS, FE, DM, 0);
        if (fm & 128) launch_mega(ma, pb + 7, pb + 8, stream);
        else nv_gemm<ABF, BExp, EDown, 1><<<dim3(DM / 64, NPADROWS / 64), 256, 0, stream>>>(ABF{(const bf16_t*)(ws + WS_ACTB), FE},
            BExp{w_dn, (const int*)(ws + WS_PANE), (size_t)FE * DM, DM, 0}, EDown{b_dn, (const int*)(ws + WS_PANE), (const float*)(ws + WS_RW), (bf16_t*)(ws + WS_YS)}, (const int*)(ws + WS_PANE) + 511, NPADROWS, DM, FE, 0);
        if (fm & 256) launch_mega(ma, pb + 8, pb + 9, stream);
        else k_combine<<<NTOK / 4, 256, 0, stream>>>(ws, ln2g, ln2b, xnext, l == 0 ? (bf16_t*)(ws + WS_XB) : nullptr);
    }
}
```

```cpp
#include <hip/hip_runtime.h>
#include <stdint.h>
#include <stdio.h>

#define DI __device__ __forceinline__
#ifndef PROBE_REP
#define PROBE_REP 0
#endif
typedef unsigned short bf16_t;
typedef unsigned u32x4_t __attribute__((ext_vector_type(4)));

constexpr int NTOK = 16384, DM = 1024, SEQ = 2048, NBATCH = 8;
constexpr int IN_W = 6912;
constexpr int NE = 32, TOPK = 4, FE = 1024;
constexpr int MAXPANELS = 288;
constexpr int NPADROWS = MAXPANELS * 256;
constexpr float LOG2E = 1.4426950408889634f;
constexpr float C2 = 0.125f * 1.4426950408889634f;
constexpr float DN_ALPHA = 1.4142135623730951f;
constexpr float LN_EPS = 1e-5f;
constexpr float SWI_LIMIT = 7.0f, SWI_ALPHA = 1.702f;
constexpr int NRB = 256;

constexpr size_t MiB = 1u << 20;
constexpr size_t WS_CTL = 0;
constexpr size_t WS_TOPI = 1 * MiB;
constexpr size_t WS_TOPW = WS_TOPI + 256 * 1024;
constexpr size_t WS_TSLOT = WS_TOPW + 256 * 1024;
constexpr size_t WS_RTOK = WS_TSLOT + 256 * 1024;
constexpr size_t WS_RW = WS_RTOK + 512 * 1024;
constexpr size_t WS_HIST = WS_RW + 512 * 1024;
constexpr size_t WS_PANE = WS_HIST + 64 * 1024;
constexpr size_t WS_LOGIT = 4 * MiB;
constexpr size_t WS_W = 8 * MiB;
constexpr size_t WL_IN = 0, WL_OUT = 14 * MiB, WL_BR = 16 * MiB, WL_UP = 19 * MiB, WL_DN = 147 * MiB, WL_BYTES = 211 * MiB;
constexpr size_t WS_ACT = WS_W + 2 * WL_BYTES;
constexpr size_t WS_XB = WS_ACT;
constexpr size_t WS_XF = WS_XB + 32 * MiB;
constexpr size_t WS_QA = WS_XF + 64 * MiB;
constexpr size_t WS_KA = WS_QA + 16 * MiB;
constexpr size_t WS_QB = WS_KA + 4 * MiB;
constexpr size_t WS_KB = WS_QB + 16 * MiB;
constexpr size_t WS_QC = WS_KB + 16 * MiB;
constexpr size_t WS_KC = WS_QC + 16 * MiB;
constexpr size_t WS_G = WS_KC + 16 * MiB;
constexpr size_t WS_VT = WS_G + 96 * MiB;
constexpr size_t WS_BR = WS_VT + 40 * MiB;
constexpr size_t WS_MF = WS_BR + 48 * MiB;
constexpr size_t WS_MB = WS_MF + 64 * MiB;
constexpr size_t WS_Y = WS_MB + 32 * MiB;
constexpr size_t WS_X1F = WS_Y + 64 * MiB;
constexpr size_t WS_X1B = WS_X1F + 64 * MiB;
constexpr size_t WS_XS = WS_X1B + 32 * MiB;
constexpr size_t WS_ACTB = WS_XS + 144 * MiB;
constexpr size_t WS_YS = WS_ACTB + 144 * MiB;
constexpr size_t WS_END = WS_YS + 144 * MiB;
static_assert(WS_END <= 2048 * MiB, "workspace map");

DI float bf2f(bf16_t v) { return __uint_as_float(((unsigned)v) << 16); }
DI bf16_t f2bf(float f) { unsigned u = __float_as_uint(f); return (bf16_t)((u + 0x7fffu + ((u >> 16) & 1u)) >> 16); }
template <int CTRL> DI float dppf(float v) { return __int_as_float(__builtin_amdgcn_update_dpp(0, __float_as_int(v), CTRL, 0xF, 0xF, true)); }
DI float wave_sum(float v) {
    v += dppf<0xB1>(v); v += dppf<0x4E>(v); v += dppf<0x141>(v); v += dppf<0x140>(v);
    { auto r = __builtin_amdgcn_permlane16_swap(__float_as_uint(v), __float_as_uint(v), false, false); v = __uint_as_float(r[0]) + __uint_as_float(r[1]); }
    { auto r = __builtin_amdgcn_permlane32_swap(__float_as_uint(v), __float_as_uint(v), false, false); v = __uint_as_float(r[0]) + __uint_as_float(r[1]); }
    return v;
}
DI float wave_max(float v) {
    v = fmaxf(v, dppf<0xB1>(v)); v = fmaxf(v, dppf<0x4E>(v)); v = fmaxf(v, dppf<0x141>(v)); v = fmaxf(v, dppf<0x140>(v));
    { auto r = __builtin_amdgcn_permlane16_swap(__float_as_uint(v), __float_as_uint(v), false, false); v = fmaxf(__uint_as_float(r[0]), __uint_as_float(r[1])); }
    { auto r = __builtin_amdgcn_permlane32_swap(__float_as_uint(v), __float_as_uint(v), false, false); v = fmaxf(__uint_as_float(r[0]), __uint_as_float(r[1])); }
    return v;
}
DI float sigmoidf_(float x) { return 1.f / (1.f + __expf(-x)); }
DI float dot64_bf(const float (&q)[64], const bf16_t* kp) {
    float acc = 0.f;
#pragma unroll
    for (int c = 0; c < 8; ++c) {
        const u32x4_t v = *(const u32x4_t*)(kp + 8 * c);
#pragma unroll
        for (int i = 0; i < 4; ++i) {
            acc += q[8 * c + 2 * i] * __uint_as_float(v[i] << 16);
            acc += q[8 * c + 2 * i + 1] * __uint_as_float(v[i] & 0xffff0000u);
        }
    }
    return acc;
}
DI void load_q64(float (&q)[64], const bf16_t* qp) {
#pragma unroll
    for (int c = 0; c < 8; ++c) {
        const u32x4_t v = *(const u32x4_t*)(qp + 8 * c);
#pragma unroll
        for (int i = 0; i < 4; ++i) { q[8 * c + 2 * i] = __uint_as_float(v[i] << 16); q[8 * c + 2 * i + 1] = __uint_as_float(v[i] & 0xffff0000u); }
    }
}

struct AF32 { const float* p; int ld; int pad; DI float operator()(int m, int k) const { return p[(size_t)m * ld + k]; } };
struct ABF { const bf16_t* p; int ld; int pad; DI float operator()(int m, int k) const { return bf2f(p[(size_t)m * ld + k]); } };
struct AGather { const float* x; const int* row_tok; DI float operator()(int m, int k) const { const int t = row_tok[m]; return (t < 0 || t >= NTOK) ? 0.f : x[(size_t)t * DM + k]; } };
struct BKN { const float* p; int ld; int off2; DI float operator()(int a, int, int k, int n) const { return p[(size_t)k * ld + n + a * off2]; } };
struct BExp { const float* w; const int* panel_e; size_t estride; int ld; int off2;
    DI float operator()(int a, int m0, int k, int n) const { const int e = panel_e[m0 >> 8]; return w[(size_t)e * estride + (size_t)k * ld + n + a * off2]; } };

template <class AF, class BF, class EF, int NACC>
__global__ void __launch_bounds__(256) nv_gemm(AF af, BF bf, EF ef, const int* mlimit, int M, int N, int K, int pad) {
    __shared__ float As[16][65];
    __shared__ float Bs[NACC][16][65];
    const int m0 = blockIdx.y * 64, n0 = blockIdx.x * 64;
    if (mlimit && m0 >= (*mlimit) * 256) return;
    const int tx = threadIdx.x & 15, ty = threadIdx.x >> 4;
    float acc[NACC][4][4];
#pragma unroll
    for (int a = 0; a < NACC; ++a)
#pragma unroll
        for (int i = 0; i < 4; ++i)
#pragma unroll
            for (int j = 0; j < 4; ++j) acc[a][i][j] = 0.f;
    for (int k0 = 0; k0 < K; k0 += 16) {
#pragma unroll
        for (int i = 0; i < 4; ++i) {
            const int t = threadIdx.x + i * 256;
            { const int m = t >> 4, k = t & 15; As[k][m] = af(m0 + m, k0 + k); }
            { const int k = t >> 6, n = t & 63;
#pragma unroll
                for (int a = 0; a < NACC; ++a) Bs[a][k][n] = (n0 + n < N) ? bf(a, m0, k0 + k, n0 + n) : 0.f; }
        }
        __syncthreads();
#pragma unroll
        for (int kk = 0; kk < 16; ++kk) {
            float av[4], bv[NACC][4];
#pragma unroll
            for (int i = 0; i < 4; ++i) av[i] = As[kk][ty * 4 + i];
#pragma unroll
            for (int a = 0; a < NACC; ++a)
#pragma unroll
                for (int j = 0; j < 4; ++j) bv[a][j] = Bs[a][kk][tx * 4 + j];
#pragma unroll
            for (int a = 0; a < NACC; ++a)
#pragma unroll
                for (int i = 0; i < 4; ++i)
#pragma unroll
                    for (int j = 0; j < 4; ++j) acc[a][i][j] += av[i] * bv[a][j];
        }
        __syncthreads();
    }
#pragma unroll
    for (int i = 0; i < 4; ++i)
#pragma unroll
        for (int j = 0; j < 4; ++j) { const int m = m0 + ty * 4 + i, n = n0 + tx * 4 + j; if (n < N) ef(m, n, acc[0][i][j], acc[NACC - 1][i][j]); }
}

struct EInProj {
    unsigned char* ws;
    DI void operator()(int m, int n, float a, float) const {
        bf16_t* QA = (bf16_t*)(ws + WS_QA); bf16_t* KA = (bf16_t*)(ws + WS_KA); bf16_t* QB = (bf16_t*)(ws + WS_QB); bf16_t* KB = (bf16_t*)(ws + WS_KB);
        bf16_t* QC = (bf16_t*)(ws + WS_QC); bf16_t* KC = (bf16_t*)(ws + WS_KC); bf16_t* G = (bf16_t*)(ws + WS_G); bf16_t* VT = (bf16_t*)(ws + WS_VT);
        if (n < 512) QA[(size_t)m * 512 + n] = f2bf(a * C2);
        else if (n < 640) KA[(size_t)m * 128 + (n - 512)] = f2bf(a);
        else if (n < 768) VT[(size_t)(n - 640) * NTOK + m] = f2bf(a);
        else if (n < 1280) QB[(size_t)m * 512 + (n - 768)] = f2bf(a * C2);
        else if (n < 1792) KB[(size_t)m * 512 + (n - 1280)] = f2bf(a);
        else if (n < 2304) VT[(size_t)(128 + n - 1792) * NTOK + m] = f2bf(a);
        else if (n < 2816) QC[(size_t)m * 512 + (n - 2304)] = f2bf(a * C2);
        else if (n < 3328) KC[(size_t)m * 512 + (n - 2816)] = f2bf(a);
        else if (n < 3840) VT[(size_t)(640 + n - 3328) * NTOK + m] = f2bf(a);
        else G[(size_t)m * 3072 + (n - 3840)] = f2bf(sigmoidf_(a));
    }
};
struct EBranch { unsigned char* ws; int i; int pad;
    DI void operator()(int m, int n, float a, float) const {
        const bf16_t* G = (const bf16_t*)(ws + WS_G); float* MF = (float*)(ws + WS_MF); bf16_t* MB = (bf16_t*)(ws + WS_MB);
        float v = bf2f(G[(size_t)m * 3072 + i * 1024 + n]) * a; const size_t idx = (size_t)m * DM + n;
        if (i > 0) v += MF[idx];
        MF[idx] = v; if (i == 2) MB[idx] = f2bf(v);
    }
};
struct EWout { const float* x; float* Y; DI void operator()(int m, int n, float a, float) const { const size_t idx = (size_t)m * DM + n; Y[idx] = DN_ALPHA * x[idx] + a; } };
struct EUp { const float* b_up; const int* panel_e; bf16_t* ACT;
    DI void operator()(int m, int n, float hg, float hl) const {
        const int e = panel_e[m >> 8]; hg += b_up[e * 2048 + n]; hl += b_up[e * 2048 + 1024 + n];
        hg = fminf(hg, SWI_LIMIT); hl = fminf(fmaxf(hl, -SWI_LIMIT), SWI_LIMIT);
        ACT[(size_t)m * FE + n] = f2bf(hg * sigmoidf_(SWI_ALPHA * hg) * (hl + 1.f));
    }
};
struct EDown { const float* b_dn; const int* panel_e; const float* row_w; bf16_t* YS;
    DI void operator()(int m, int n, float a, float) const { const int e = panel_e[m >> 8]; YS[(size_t)m * DM + n] = f2bf((a + b_dn[e * DM + n]) * row_w[m]); }
};

__global__ void __launch_bounds__(256) nv_attn_a(const bf16_t* QA, const bf16_t* KA, const bf16_t* VT, bf16_t* OA, const float* sink) {
    __shared__ float ps[4][320];
    const int w = threadIdx.x >> 6, lane = threadIdx.x & 63;
    const int item = blockIdx.x * 4 + w, tok = item >> 3, h = item & 7, g = h >> 2, b = tok >> 11, s = tok & 2047;
    float q[64]; load_q64(q, QA + (size_t)tok * 512 + h * 64);
    const float slope = exp2f(-8.f * (float)(h + 1) / 12.f) * LOG2E, sk = sink[h] * LOG2E;
    float sc[5]; float mx = sk;
#pragma unroll
    for (int i = 0; i < 5; ++i) {
        const int j = s - 128 + lane + 64 * i; float v = -INFINITY;
        if (j >= 0 && j < SEQ && j <= s + 128) v = dot64_bf(q, KA + (size_t)(b * SEQ + j) * 128 + g * 64) - slope * fabsf((float)(j - s));
        sc[i] = v; mx = fmaxf(mx, v);
    }
    mx = wave_max(mx);
    float l = 0.f;
#pragma unroll
    for (int i = 0; i < 5; ++i) { sc[i] = exp2f(sc[i] - mx); l += sc[i]; }
    l = wave_sum(l) + exp2f(sk - mx);
    const float rl = 1.f / l;
#pragma unroll
    for (int i = 0; i < 5; ++i) ps[w][lane + 64 * i] = sc[i] * rl;
    __syncthreads();
    float o = 0.f; const bf16_t* vp = VT + (size_t)(g * 64 + lane) * NTOK + (size_t)b * SEQ;
    for (int jj = 0; jj < 320; ++jj) { const int j = s - 128 + jj; if (j >= 0 && j < SEQ) o += ps[w][jj] * bf2f(vp[j]); }
    OA[(size_t)tok * 512 + h * 64 + lane] = f2bf(o);
}
__global__ void __launch_bounds__(256) nv_attn_c(const bf16_t* QC, const bf16_t* KC, const bf16_t* VT, bf16_t* OC, const float* rpb  ) {
    __shared__ float ps[4][128];
    const int w = threadIdx.x >> 6, lane = threadIdx.x & 63;
    const int item = blockIdx.x * 4 + w, tok = item >> 3, h = item & 7, b = tok >> 11, s = tok & 2047;
    const int r = s >> 6, qc = s & 63; const int rs = min(max(r - 4, 0), 24), cs = min(max(qc - 8, 0), 48);
    float q[64]; load_q64(q, QC + (size_t)tok * 512 + h * 64);
    float sc[2]; float mx = -INFINITY;
#pragma unroll
    for (int i = 0; i < 2; ++i) {
        const int kk = lane + 64 * i, kr = rs + (kk >> 4), kc = cs + (kk & 15), j = kr * 64 + kc;
        sc[i] = dot64_bf(q, KC + (size_t)(b * SEQ + j) * 512 + h * 64) + rpb[(h * 15 + (kr - r + 7)) * 31 + (kc - qc + 15)] * LOG2E;
        mx = fmaxf(mx, sc[i]);
    }
    mx = wave_max(mx);
    float l = 0.f;
#pragma unroll
    for (int i = 0; i < 2; ++i) { sc[i] = exp2f(sc[i] - mx); l += sc[i]; }
    l = wave_sum(l); const float rl = 1.f / l;
#pragma unroll
    for (int i = 0; i < 2; ++i) ps[w][lane + 64 * i] = sc[i] * rl;
    __syncthreads();
    float o = 0.f; const bf16_t* vp = VT + (size_t)(640 + h * 64 + lane) * NTOK + (size_t)b * SEQ;
    for (int kk = 0; kk < 128; ++kk) { const int j = (rs + (kk >> 4)) * 64 + cs + (kk & 15); o += ps[w][kk] * bf2f(vp[j]); }
    OC[(size_t)tok * 512 + h * 64 + lane] = f2bf(o);
}
__global__ void __launch_bounds__(256) nv_attn_b(const bf16_t* QB, const bf16_t* KB, const bf16_t* VT, bf16_t* OB, const float* lq1, const float* lk1, const float* lq2, const float* lk2,
                                                 const float* gain, float lam_init) {
    __shared__ float as[4][2048];
    const int w = threadIdx.x >> 6, lane = threadIdx.x & 63;
    const int item = blockIdx.x * 4 + w, tok = item >> 2, h = item & 3, b = tok >> 11, s = tok & 2047;
    const float lam = __expf(wave_sum(lq1[lane] * lk1[lane])) - __expf(wave_sum(lq2[lane] * lk2[lane])) + lam_init;
    const float slope = exp2f(-8.f * (float)(8 + h + 1) / 12.f) * LOG2E;
    float p1[32];
    {
        float q[64]; load_q64(q, QB + (size_t)tok * 512 + h * 128);
        float mx = -INFINITY;
#pragma unroll
        for (int i = 0; i < 32; ++i) { const int j = lane + 64 * i; p1[i] = dot64_bf(q, KB + (size_t)(b * SEQ + j) * 512 + h * 128) - slope * fabsf((float)(j - s)); mx = fmaxf(mx, p1[i]); }
        mx = wave_max(mx); float l = 0.f;
#pragma unroll
        for (int i = 0; i < 32; ++i) { p1[i] = exp2f(p1[i] - mx); l += p1[i]; }
        l = wave_sum(l); const float rl = 1.f / l;
#pragma unroll
        for (int i = 0; i < 32; ++i) p1[i] *= rl;
    }
    {
        float q[64]; load_q64(q, QB + (size_t)tok * 512 + h * 128 + 64);
        float p2[32]; float mx = -INFINITY;
#pragma unroll
        for (int i = 0; i < 32; ++i) { const int j = lane + 64 * i; p2[i] = dot64_bf(q, KB + (size_t)(b * SEQ + j) * 512 + h * 128 + 64) - slope * fabsf((float)(j - s)); mx = fmaxf(mx, p2[i]); }
        mx = wave_max(mx); float l = 0.f;
#pragma unroll
        for (int i = 0; i < 32; ++i) { p2[i] = exp2f(p2[i] - mx); l += p2[i]; }
        l = wave_sum(l); const float rl = lam / l;
#pragma unroll
        for (int i = 0; i < 32; ++i) as[w][lane + 64 * i] = p1[i] - p2[i] * rl;
    }
    __syncthreads();
    float o0 = 0.f, o1 = 0.f;
    const bf16_t* v0 = VT + (size_t)(128 + h * 128 + lane) * NTOK + (size_t)b * SEQ; const bf16_t* v1 = v0 + (size_t)64 * NTOK;
    for (int j8 = 0; j8 < 256; ++j8) {
        const u32x4_t a = *(const u32x4_t*)(v0 + 8 * j8), c = *(const u32x4_t*)(v1 + 8 * j8);
#pragma unroll
        for (int i = 0; i < 4; ++i) {
            const float pa = as[w][8 * j8 + 2 * i], pb = as[w][8 * j8 + 2 * i + 1];
            o0 += pa * __uint_as_float(a[i] << 16) + pb * __uint_as_float(a[i] & 0xffff0000u);
            o1 += pa * __uint_as_float(c[i] << 16) + pb * __uint_as_float(c[i] & 0xffff0000u);
        }
    }
    const float ssq = wave_sum(o0 * o0 + o1 * o1), rr = rsqrtf(ssq * (1.f / 128.f) + LN_EPS) * (1.f - lam_init);
    OB[(size_t)tok * 512 + h * 128 + lane] = f2bf(o0 * rr * gain[lane]);
    OB[(size_t)tok * 512 + h * 128 + 64 + lane] = f2bf(o1 * rr * gain[64 + lane]);
}

DI void ln_row(const float* src, const float* g, const float* bta, float* dstF, bf16_t* dstB, int lane) {
    typedef float f4 __attribute__((ext_vector_type(4)));
    f4 v[4]; float s = 0.f;
#pragma unroll
    for (int j = 0; j < 4; ++j) { v[j] = *(const f4*)(src + 256 * j + 4 * lane); s += (v[j].x + v[j].y) + (v[j].z + v[j].w); }
    const float mean = wave_sum(s) * (1.f / DM); float s2 = 0.f;
#pragma unroll
    for (int j = 0; j < 4; ++j) { v[j] = v[j] - mean; s2 += (v[j].x * v[j].x + v[j].y * v[j].y) + (v[j].z * v[j].z + v[j].w * v[j].w); }
    const float rstd = rsqrtf(wave_sum(s2) * (1.f / DM) + LN_EPS);
#pragma unroll
    for (int j = 0; j < 4; ++j) {
        const f4 gg = *(const f4*)(g + 256 * j + 4 * lane), bb = *(const f4*)(bta + 256 * j + 4 * lane);
        const f4 o = v[j] * rstd * gg + bb;
        *(f4*)(dstF + 256 * j + 4 * lane) = o;
        if (dstB) { uint2 pk; pk.x = (unsigned)f2bf(o.x) | ((unsigned)f2bf(o.y) << 16); pk.y = (unsigned)f2bf(o.z) | ((unsigned)f2bf(o.w) << 16); *(uint2*)(dstB + 256 * j + 4 * lane) = pk; }
    }
}
DI void topk_token(const float* lg, int* ti, float* tw) {
    float v[32];
#pragma unroll
    for (int e = 0; e < 32; ++e) v[e] = lg[e];
    int idx[4]; float val[4];
#pragma unroll
    for (int k = 0; k < 4; ++k) {
        float best = -INFINITY; int bi = 0;
#pragma unroll
        for (int e = 0; e < 32; ++e) { const bool taken = (k > 0 && idx[0] == e) || (k > 1 && idx[1] == e) || (k > 2 && idx[2] == e); if (!taken && v[e] > best) { best = v[e]; bi = e; } }
        idx[k] = bi; val[k] = best;
    }
    float l = 0.f, ex[4];
#pragma unroll
    for (int k = 0; k < 4; ++k) { ex[k] = __expf(val[k] - val[0]); l += ex[k]; }
#pragma unroll
    for (int k = 0; k < 4; ++k) { ti[k] = idx[k]; tw[k] = ex[k] / l; }
}
DI void hist_block(const int* topi, int* hist, int vb, int* lds_hist) {
    if (threadIdx.x < 32) lds_hist[threadIdx.x] = 0;
    __syncthreads();
    for (int a = threadIdx.x; a < 256; a += blockDim.x) atomicAdd(&lds_hist[topi[vb * 256 + a]], 1);
    __syncthreads();
    if (threadIdx.x < 32) hist[vb * 32 + threadIdx.x] = lds_hist[threadIdx.x];
    __syncthreads();
}
DI void dispatch_block(unsigned char* ws, int vb, int* lds) {
    const int* hist = (const int*)(ws + WS_HIST); const int* topi = (const int*)(ws + WS_TOPI); const float* topw = (const float*)(ws + WS_TOPW);
    int* tslot = (int*)(ws + WS_TSLOT); int* rtok = (int*)(ws + WS_RTOK); float* rw = (float*)(ws + WS_RW); int* pane = (int*)(ws + WS_PANE);
    int* cnt = lds, *base = lds + 32, *pstart = lds + 64, *npan = lds + 96;
    if (threadIdx.x < 32) { const int e = threadIdx.x; int c = 0, bsum = 0; for (int b2 = 0; b2 < NRB; ++b2) { const int hv = hist[b2 * 32 + e]; c += hv; if (b2 < vb) bsum += hv; } cnt[e] = c; base[e] = bsum; }
    __syncthreads();
    if (threadIdx.x == 0) { int acc = 0; for (int e = 0; e < 32; ++e) { pstart[e] = acc; acc += ((cnt[e] + 255) >> 8) << 8; } npan[0] = acc >> 8; }
    __syncthreads();
    if (threadIdx.x < 32) {
        const int e = threadIdx.x; int slot = pstart[e] + base[e];
        for (int a = 0; a < 256; ++a) { if (topi[vb * 256 + a] == e) { tslot[vb * 256 + a] = slot; rtok[slot] = vb * 64 + (a >> 2); rw[slot] = topw[vb * 256 + a]; ++slot; } }
        if (vb == 0) { const int p0 = pstart[e] >> 8, p1 = p0 + ((cnt[e] + 255) >> 8); for (int p = p0; p < p1; ++p) pane[p] = e; if (e == 0) pane[511] = npan[0]; }
    }
    __syncthreads();
    const bf16_t* x1b = (const bf16_t*)(ws + WS_X1B); bf16_t* xs = (bf16_t*)(ws + WS_XS);
    for (int i = threadIdx.x; i < 256 * 128; i += blockDim.x) {
        const int a = i >> 7, c = i & 127; const int slot = tslot[vb * 256 + a];
        *(u32x4_t*)(xs + (size_t)slot * DM + 8 * c) = *(const u32x4_t*)(x1b + (size_t)(vb * 64 + (a >> 2)) * DM + 8 * c);
    }
    __syncthreads();
}
DI void combine_row(unsigned char* ws, int tok, const float* g, const float* bta, float* outF, bf16_t* outB, int lane) {
    typedef float f4 __attribute__((ext_vector_type(4)));
    const float* x1 = (const float*)(ws + WS_X1F) + (size_t)tok * DM; const bf16_t* ys = (const bf16_t*)(ws + WS_YS); const int* tslot = (const int*)(ws + WS_TSLOT) + tok * 4;
    f4 v[4]; float s = 0.f;
#pragma unroll
    for (int j = 0; j < 4; ++j) v[j] = *(const f4*)(x1 + 256 * j + 4 * lane) * DN_ALPHA;
#pragma unroll
    for (int k = 0; k < 4; ++k) { const bf16_t* yr = ys + (size_t)tslot[k] * DM;
#pragma unroll
        for (int j = 0; j < 4; ++j) { const uint2 pk = *(const uint2*)(yr + 256 * j + 4 * lane);
            v[j].x += __uint_as_float(pk.x << 16); v[j].y += __uint_as_float(pk.x & 0xffff0000u); v[j].z += __uint_as_float(pk.y << 16); v[j].w += __uint_as_float(pk.y & 0xffff0000u); } }
#pragma unroll
    for (int j = 0; j < 4; ++j) s += (v[j].x + v[j].y) + (v[j].z + v[j].w);
    const float mean = wave_sum(s) * (1.f / DM); float s2 = 0.f;
#pragma unroll
    for (int j = 0; j < 4; ++j) { v[j] = v[j] - mean; s2 += (v[j].x * v[j].x + v[j].y * v[j].y) + (v[j].z * v[j].z + v[j].w * v[j].w); }
    const float rstd = rsqrtf(wave_sum(s2) * (1.f / DM) + LN_EPS);
#pragma unroll
    for (int j = 0; j < 4; ++j) {
        const f4 gg = *(const f4*)(g + 256 * j + 4 * lane), bb = *(const f4*)(bta + 256 * j + 4 * lane);
        const f4 o = v[j] * rstd * gg + bb;
        *(f4*)(outF + (size_t)tok * DM + 256 * j + 4 * lane) = o;
        if (outB) { uint2 pk; pk.x = (unsigned)f2bf(o.x) | ((unsigned)f2bf(o.y) << 16); pk.y = (unsigned)f2bf(o.z) | ((unsigned)f2bf(o.w) << 16); *(uint2*)(outB + (size_t)tok * DM + 256 * j + 4 * lane) = pk; }
    }
}

__global__ void __launch_bounds__(256) k_ln1(const float* Y, const float* g, const float* b, float* X1F, bf16_t* X1B) {
    const int row = blockIdx.x * 4 + (threadIdx.x >> 6); ln_row(Y + (size_t)row * DM, g, b, X1F + (size_t)row * DM, X1B + (size_t)row * DM, threadIdx.x & 63);
}
__global__ void __launch_bounds__(256) k_router_naive(const float* X1F, const float* wr, const float* br, float* logits) {
    const int gid = blockIdx.x * 256 + threadIdx.x, tok = gid >> 5, e = gid & 31; const float* x = X1F + (size_t)tok * DM; float acc = 0.f;
    for (int k = 0; k < DM; ++k) acc += x[k] * wr[k * 32 + e];
    logits[gid] = acc + br[e];
}
__global__ void __launch_bounds__(256) k_topk(const float* logits, int* ti, float* tw) { const int tok = blockIdx.x * 256 + threadIdx.x; topk_token(logits + tok * 32, ti + tok * 4, tw + tok * 4); }
__global__ void __launch_bounds__(256) k_hist(unsigned char* ws) { __shared__ int lh[32]; hist_block((const int*)(ws + WS_TOPI), (int*)(ws + WS_HIST), blockIdx.x, lh); }
__global__ void __launch_bounds__(256) k_dispatch(unsigned char* ws) { __shared__ int l[128]; dispatch_block(ws, blockIdx.x, l); }
__global__ void __launch_bounds__(256) k_combine(unsigned char* ws, const float* g, const float* b, float* outF, bf16_t* outB) {
    const int tok = blockIdx.x * 4 + (threadIdx.x >> 6); combine_row(ws, tok, g, b, outF, outB, threadIdx.x & 63);
}

namespace pg8 {
#define PG8_LAS __attribute__((address_space(3)))
typedef unsigned short bf16_t;
typedef short bf16x8 __attribute__((ext_vector_type(8)));
typedef float f32x4 __attribute__((ext_vector_type(4)));
typedef unsigned u32x4 __attribute__((ext_vector_type(4)));
constexpr int BM = 256, BK = 64, HALF = 128, HTB = HALF * BK * 2  , STAGE_BYTES = 8 * HTB, NXCD = 8, WGM = 8;

__host__ __device__ __forceinline__ int lds_byte(int r, int c) { const int st = (r >> 4) * 2 + (c >> 5), rr = r & 15, cc = c & 31, ob = rr * 64 + cc * 2; return st * 1024 + (ob ^ (((ob >> 9) & 1) << 5)); }
__host__ __device__ __forceinline__ void stage_rc(int b, int& R, int& C) { const int st = b / 1024, sb = b % 1024, swz = sb ^ (((sb >> 9) & 1) << 5); R = (st >> 1) * 16 + swz / 64; C = (st & 1) * 32 + (swz % 64) / 2; }
__host__ __device__ __forceinline__ int perm32(int rho) { const int n = rho >> 4, i = rho & 15; return 8 * (i >> 2) + 4 * n + (i & 3); }

struct Unit { int pm, pn; };
struct Gemm { const bf16_t* A; const bf16_t* Bt; int M, N, K; };

struct StaticOrder {
    int nM, nN, nwg, G, c;
    __host__ __device__ void init(int M, int N, int G_, int c_) { nM = M / BM; nN = N / BM; nwg = nM * nN; G = G_; c = c_; }
    __host__ __device__ bool next(int i, Unit& u) const {
        const long L = (long)i * G + c; if (L >= nwg) return false;
        int wgid = (int)L; { const int q = nwg / NXCD, r = nwg % NXCD, xcd = wgid % NXCD, off = wgid / NXCD; wgid = (xcd < r ? xcd * (q + 1) : r * (q + 1) + (xcd - r) * q) + off; }
        const int nig = WGM * nN, gid = wgid / nig, fm = gid * WGM, gsz = (nM - fm) < WGM ? (nM - fm) : WGM;
        u.pm = fm + ((wgid % nig) % gsz); u.pn = (wgid % nig) / gsz; return true;
    }
    __device__ __forceinline__ void a_ready(const Unit&) const {}
    __device__ __forceinline__ void done(const Unit&) const {}
};
__device__ __forceinline__ unsigned cvt_pk_bf16(float lo, float hi) { unsigned r; asm volatile("v_cvt_pk_bf16_f32 %0, %1, %2" : "=v"(r) : "v"(lo), "v"(hi)); return r; }
typedef float f32x2 __attribute__((ext_vector_type(2)));
typedef int v8i32 __attribute__((ext_vector_type(8)));
typedef short s16x16 __attribute__((ext_vector_type(16)));
#define PG8_CAT(x, y) __builtin_bit_cast(v8i32, __builtin_shufflevector((x), (y), 0, 1, 2, 3, 4, 5, 6, 7, 8, 9, 10, 11, 12, 13, 14, 15))
template <class Epi, class Sched, bool ALIGN_EPI = false, bool SP2 = false, bool F8 = false>
__device__ __forceinline__ void gemm_phase(PG8_LAS unsigned char* lds, const Gemm g, const Sched& S, const Epi& E, const int wid_in) {
    unsigned ones_ = ~0u; asm volatile("" : "+s"(ones_)); const int tid = wid_in * 64 + (int)__builtin_amdgcn_mbcnt_hi(ones_, __builtin_amdgcn_mbcnt_lo(ones_, 0u));
    const int wid = __builtin_amdgcn_readfirstlane(tid >> 6), lane = tid & 63, wr = wid >> 2, wc = wid & 3, fr = lane & 15, fq = lane >> 4;
    const int K = g.K, nt = K / BK; const int f8_sw = g.M, f8_one = 127; (void)f8_sw; (void)f8_one;
    unsigned voffA[2], voffB[2];
#pragma unroll
    for (int i = 0; i < 2; ++i) { int R, C; stage_rc(tid * 16 + i * 8192, R, C); const int Rb = Epi::PERM ? ((R & ~31) + perm32(R & 31)) : R;
        voffA[i] = (unsigned)(R * K + C) * 2u; voffB[i] = (unsigned)(Rb * K + C) * 2u; }
    const size_t kstep = (size_t)(BK * 2);
    const size_t hstep = (size_t)HALF * K * 2;
    const size_t tstep = 2 * hstep;
    const unsigned ldsw = (unsigned)wid * 1024u;
    const int aoff = lds_byte(wr * 64 + fr, fq * 8), boff = lds_byte(wc * 32 + fr, fq * 8);
#define PG8_SA(b, h) (((b) * 2 + (h)) * HTB)
#define PG8_SB(b, h) ((4 + (b) * 2 + (h)) * HTB)
#define PG8_STAGE(bufoff, gbase, voff) do { _Pragma("unroll") for (int _i = 0; _i < 2; ++_i) \
        __builtin_amdgcn_global_load_lds((const unsigned*)((const char*)(gbase) + (voff)[_i]), (PG8_LAS unsigned*)(lds + (bufoff) + ldsw + _i * 8192), 16, 0, 0); } while (0)
#define PG8_LDA(dst, b, h) do { _Pragma("unroll") for (int m = 0; m < 4; ++m) { if constexpr (F8) dst##8[m] = PG8_CAT(*(const PG8_LAS bf16x8*)(lds + PG8_SA(b, h) + aoff + m * 2048), *(const PG8_LAS bf16x8*)(lds + PG8_SA(b, h) + aoff + m * 2048 + 1024)); \
        else { _Pragma("unroll") for (int k = 0; k < 2; ++k) dst[m][k] = *(const PG8_LAS bf16x8*)(lds + PG8_SA(b, h) + aoff + m * 2048 + k * 1024); } } } while (0)
#define PG8_LDB(dst, b, h) do { _Pragma("unroll") for (int n = 0; n < 2; ++n) { if constexpr (F8) dst##8[n] = PG8_CAT(*(const PG8_LAS bf16x8*)(lds + PG8_SB(b, h) + boff + n * 2048), *(const PG8_LAS bf16x8*)(lds + PG8_SB(b, h) + boff + n * 2048 + 1024)); \
        else { _Pragma("unroll") for (int k = 0; k < 2; ++k) dst[n][k] = *(const PG8_LAS bf16x8*)(lds + PG8_SB(b, h) + boff + n * 2048 + k * 1024); } } } while (0)
#define PG8_MMA(ai, bj, At, Bt) do { __builtin_amdgcn_s_setprio(1); _Pragma("unroll") for (int m = 0; m < 4; ++m) _Pragma("unroll") for (int n = 0; n < 2; ++n) { \
        if constexpr (F8) asm volatile("v_mfma_scale_f32_16x16x128_f8f6f4 %0, %1, %2, %0, %3, %4 op_sel_hi:[0,0,0]" : "+v"(acc[ai][bj][m][n]) : "v"(Bt##8[n]), "v"(At##8[m]), "v"(f8_sw), "v"(f8_one));     \
        else { _Pragma("unroll") for (int k = 0; k < 2; ++k) acc[ai][bj][m][n] = __builtin_amdgcn_mfma_f32_16x16x32_bf16(Bt[n][k], At[m][k], acc[ai][bj][m][n], 0, 0, 0); } } __builtin_amdgcn_s_setprio(0); } while (0)
#define PG8_WAIT_V(n) asm volatile("s_waitcnt vmcnt(" #n ")" ::: "memory")
#define PG8_WAIT_L(n) asm volatile("s_waitcnt lgkmcnt(" #n ")" ::: "memory")
#define PG8_BAR __builtin_amdgcn_s_barrier()
#define PG8_SCHED __builtin_amdgcn_sched_barrier(0)
    Unit cur, nxt; int ui = 0;
    if (!S.next(0, cur)) return;
    f32x4 acc[2][2][4][2];
#pragma unroll
    for (int a = 0; a < 2; ++a)
#pragma unroll
        for (int b = 0; b < 2; ++b)
#pragma unroll
            for (int m = 0; m < 4; ++m)
#pragma unroll
                for (int n = 0; n < 2; ++n) acc[a][b][m][n] = (f32x4){0.f, 0.f, 0.f, 0.f};
    bf16x8 At[4][2], B0[2][2], B1[2][2]; v8i32 At8[4], B08[2], B18[2];
    const char* cA = (const char*)g.A + (size_t)cur.pm * tstep; const char* cB = (const char*)g.Bt + (size_t)cur.pn * tstep;
    S.a_ready(cur);
    if constexpr (SP2) {
        PG8_STAGE(PG8_SB(0, 0), cB, voffB); PG8_STAGE(PG8_SB(0, 1), cB + hstep, voffB); PG8_STAGE(PG8_SA(0, 0), cA, voffA); PG8_STAGE(PG8_SA(0, 1), cA + hstep, voffA);
        if (wr == 1) PG8_BAR;
        PG8_WAIT_V(2); PG8_BAR;
        PG8_STAGE(PG8_SB(1, 0), cB + kstep, voffB); PG8_STAGE(PG8_SA(1, 0), cA + kstep, voffA); PG8_STAGE(PG8_SB(1, 1), cB + hstep + kstep, voffB);
        PG8_WAIT_V(6); PG8_BAR;
    } else {
        PG8_STAGE(PG8_SB(0, 0), cB, voffB); PG8_STAGE(PG8_SA(0, 0), cA, voffA); PG8_STAGE(PG8_SB(0, 1), cB + hstep, voffB); PG8_STAGE(PG8_SA(0, 1), cA + hstep, voffA);
        if (wr == 1) PG8_BAR;
        PG8_WAIT_V(4); PG8_BAR;
        PG8_STAGE(PG8_SB(1, 0), cB + kstep, voffB); PG8_STAGE(PG8_SA(1, 0), cA + kstep, voffA); PG8_STAGE(PG8_SB(1, 1), cB + hstep + kstep, voffB);
        PG8_WAIT_V(6); PG8_BAR;
    }
    for (;;) {
        const bool has_next = S.next(ui + 1, nxt);
        const char* nA = has_next ? (const char*)g.A + (size_t)nxt.pm * tstep : cA; const char* nB = has_next ? (const char*)g.Bt + (size_t)nxt.pn * tstep : cB;
        for (int t = 0; t < nt; t += 2) {
            const bool last = (t == nt - 2);
            const char* a1 = cA + (size_t)(t + 1) * kstep;
            const char* a2 = last ? nA : cA + (size_t)(t + 2) * kstep; const char* b2 = last ? nB : cB + (size_t)(t + 2) * kstep;
            const char* a3 = a2 + kstep; const char* b3 = b2 + kstep;
            if (last && has_next) S.a_ready(nxt);
            if constexpr (SP2) {
            PG8_LDB(B0, 0, 0); PG8_LDB(B1, 0, 1); PG8_SCHED; PG8_LDA(At, 0, 0); PG8_STAGE(PG8_SA(1, 1), a1 + hstep, voffA);
            PG8_WAIT_V(8); PG8_WAIT_L(0); PG8_BAR; PG8_MMA(0, 0, At, B0); PG8_MMA(0, 1, At, B1); PG8_BAR; PG8_SCHED;
            PG8_LDA(At, 0, 1); PG8_STAGE(PG8_SB(0, 0), b2, voffB); PG8_STAGE(PG8_SB(0, 1), b2 + hstep, voffB); PG8_STAGE(PG8_SA(0, 0), a2, voffA);
            PG8_WAIT_V(8); PG8_WAIT_L(0); PG8_BAR; PG8_MMA(1, 0, At, B0); PG8_MMA(1, 1, At, B1); PG8_BAR; PG8_SCHED;
            PG8_LDB(B0, 1, 0); PG8_LDB(B1, 1, 1); PG8_SCHED; PG8_LDA(At, 1, 0); PG8_STAGE(PG8_SA(0, 1), a2 + hstep, voffA);
            PG8_WAIT_V(8); PG8_WAIT_L(0); PG8_BAR; PG8_MMA(0, 0, At, B0); PG8_MMA(0, 1, At, B1); PG8_BAR; PG8_SCHED;
            PG8_LDA(At, 1, 1); PG8_STAGE(PG8_SB(1, 0), b3, voffB); PG8_STAGE(PG8_SB(1, 1), b3 + hstep, voffB); PG8_STAGE(PG8_SA(1, 0), a3, voffA);
            PG8_WAIT_V(8); PG8_WAIT_L(0); PG8_BAR; PG8_MMA(1, 0, At, B0); PG8_MMA(1, 1, At, B1); PG8_BAR; PG8_SCHED;
            } else {
            PG8_LDB(B0, 0, 0); PG8_SCHED; PG8_LDA(At, 0, 0); PG8_STAGE(PG8_SA(1, 1), a1 + hstep, voffA);
            PG8_WAIT_L(8); PG8_BAR; PG8_WAIT_L(0); PG8_MMA(0, 0, At, B0); PG8_BAR; PG8_SCHED;
            PG8_LDB(B1, 0, 1); PG8_STAGE(PG8_SB(0, 0), b2, voffB);
            PG8_BAR; PG8_WAIT_L(0); PG8_MMA(0, 1, At, B1); PG8_BAR;
            PG8_LDA(At, 0, 1); PG8_STAGE(PG8_SA(0, 0), a2, voffA);
            PG8_BAR; PG8_WAIT_L(0); PG8_MMA(1, 0, At, B0); PG8_BAR; PG8_SCHED;
            PG8_STAGE(PG8_SB(0, 1), b2 + hstep, voffB);
            PG8_WAIT_V(6); PG8_BAR; PG8_MMA(1, 1, At, B1); PG8_BAR;
            PG8_LDB(B0, 1, 0); PG8_SCHED; PG8_LDA(At, 1, 0); PG8_STAGE(PG8_SA(0, 1), a2 + hstep, voffA);
            PG8_WAIT_L(8); PG8_BAR; PG8_WAIT_L(0); PG8_MMA(0, 0, At, B0); PG8_BAR; PG8_SCHED;
            PG8_LDB(B1, 1, 1); PG8_STAGE(PG8_SB(1, 0), b3, voffB);
            PG8_BAR; PG8_WAIT_L(0); PG8_MMA(0, 1, At, B1); PG8_BAR;
            PG8_LDA(At, 1, 1); PG8_STAGE(PG8_SA(1, 0), a3, voffA);
            PG8_BAR; PG8_WAIT_L(0); PG8_MMA(1, 0, At, B0); PG8_BAR; PG8_SCHED;
            PG8_STAGE(PG8_SB(1, 1), b3 + hstep, voffB);
            PG8_WAIT_V(6); PG8_BAR; PG8_MMA(1, 1, At, B1); PG8_BAR;
            }
        }
        if constexpr (ALIGN_EPI) { if (wr == 0) PG8_BAR; }
        if constexpr (!Epi::AFTER_DRAIN) { E(acc, cur, wr, wc, fr, fq); S.done(cur); }
        if (!has_next) break;
#pragma unroll
        for (int a = 0; a < 2; ++a)
#pragma unroll
            for (int b = 0; b < 2; ++b)
#pragma unroll
                for (int m = 0; m < 4; ++m)
#pragma unroll
                    for (int n = 0; n < 2; ++n) acc[a][b][m][n] = (f32x4){0.f, 0.f, 0.f, 0.f};
        cur = nxt; cA = nA; cB = nB; ++ui;
        if constexpr (ALIGN_EPI) { if (wr == 1) PG8_BAR; }
    }
    PG8_WAIT_V(0);
    if constexpr (!ALIGN_EPI) { if (wr == 0) PG8_BAR; }
    PG8_BAR;
    if constexpr (Epi::AFTER_DRAIN) { E.fused(acc, cur, wr, wc, fr, fq, lds, wid, lane); S.done(cur); }
#undef PG8_SA
#undef PG8_SB
#undef PG8_STAGE
#undef PG8_LDA
#undef PG8_LDB
#undef PG8_MMA
#undef PG8_WAIT_V
#undef PG8_WAIT_L
#undef PG8_BAR
#undef PG8_SCHED
}
}

#define GAS __attribute__((address_space(1)))
#define LAS __attribute__((address_space(3)))
typedef GAS unsigned gu32;
typedef GAS unsigned long long gu64;
#define RLX_AGENT __ATOMIC_RELAXED, __HIP_MEMORY_SCOPE_AGENT
#define XB_TMO      128
#define XB_XCNT(j)  (256  + 64 * (j))
#define XB_XSUB(j)  (1280 + 64 * (j))
#define XB_XGEN(j)  (2304 + 64 * (j))
#define XB_TOP      3328
#define XB_TOPGEN   3392
#define XCD_BAR_WORDS 3456
#define XB_SPIN_CAP (1u << 18)

__device__ __forceinline__ unsigned xb_ld(unsigned* p)              { return __hip_atomic_load(p, __ATOMIC_RELAXED, __HIP_MEMORY_SCOPE_AGENT); }
__device__ __forceinline__ unsigned xb_add(unsigned* p, unsigned v) { return __hip_atomic_fetch_add(p, v, __ATOMIC_RELAXED, __HIP_MEMORY_SCOPE_AGENT); }
__device__ __forceinline__ unsigned xb_xcc_id() { return (unsigned)__builtin_amdgcn_s_getreg((3 << 11) | 20) & 0xFu; }
#define XB_SPIN(cond, bar) do { unsigned _sp = 0; while (cond) { __builtin_amdgcn_s_sleep(1); \
    if ((++_sp & 255u) == 0u) { if (xb_ld(&(bar)[XB_TMO])) break; if (_sp > XB_SPIN_CAP) { atomicAdd(&(bar)[XB_TMO], 1u); break; } } } } while (0)

struct XcdBarrier {
    unsigned* bar; unsigned x;
    volatile LAS unsigned* st;
};

__device__ __forceinline__ XcdBarrier xcd_barrier_post(unsigned* bar, volatile LAS unsigned* st) {
    XcdBarrier b; b.bar = bar; b.x = xb_xcc_id(); b.st = st;
    if (threadIdx.x == 0) (void)xb_add(&bar[XB_XCNT(b.x)], 1u);
    return b;
}
__device__ __forceinline__ void xcd_barrier_complete(unsigned* bar, unsigned x, unsigned& nloc, unsigned& nx) {
    const unsigned G = gridDim.x * gridDim.y * gridDim.z;
    unsigned sum, cnt, mine, sp = 0u;
    for (;;) {
        sum = 0u; cnt = 0u; mine = 0u;
#pragma unroll
        for (unsigned j = 0; j < 16; ++j) { const unsigned c = xb_ld(&bar[XB_XCNT(j)]); sum += c; cnt += (c > 0u) ? 1u : 0u; mine = (j == x) ? c : mine; }
        if (sum == G) break;
        __builtin_amdgcn_s_sleep(1);
        if ((++sp & 255u) == 0u) { if (xb_ld(&bar[XB_TMO])) break; if (sp > XB_SPIN_CAP) { atomicAdd(&bar[XB_TMO], 1u); break; } }
    }
    nloc = mine > 0u ? mine : 1u; nx = cnt > 0u ? cnt : 1u;
}

__device__ __forceinline__ void xcd_barrier(const XcdBarrier& b) {
    asm volatile("s_waitcnt vmcnt(0)" ::: "memory");
    __syncthreads();
    if (threadIdx.x == 0) {
        unsigned* bar = b.bar;
        __builtin_amdgcn_s_waitcnt(0);
        unsigned nloc = b.st[0], nx = b.st[1];
        if (nloc == 0u) { xcd_barrier_complete(bar, b.x, nloc, nx); b.st[0] = nloc; b.st[1] = nx; }
        const unsigned old = xb_add(&bar[XB_XSUB(b.x)], 1u);
        const unsigned gen = old / nloc;
        if (old + 1u == (gen + 1u) * nloc) {
            __builtin_amdgcn_fence(__ATOMIC_RELEASE, "agent");
            asm volatile("s_waitcnt vmcnt(0)" ::: "memory");
            const unsigned og = xb_add(&bar[XB_TOP], 1u);
            const unsigned tg = og / nx;
            if (og + 1u == (tg + 1u) * nx) xb_add(&bar[XB_TOPGEN], 1u);
            else XB_SPIN(xb_ld(&bar[XB_TOPGEN]) == tg, bar);
            __builtin_amdgcn_fence(__ATOMIC_ACQUIRE, "agent");
            xb_add(&bar[XB_XGEN(b.x)], 1u);
            asm volatile("s_waitcnt vmcnt(0)" ::: "memory");
        } else {
            XB_SPIN(xb_ld(&bar[XB_XGEN(b.x)]) == gen, bar);
            __builtin_amdgcn_fence(__ATOMIC_ACQUIRE, "agent");
            asm volatile("s_waitcnt vmcnt(0)" ::: "memory");
        }
    }
    __syncthreads();
}

typedef short bf16x8 __attribute__((ext_vector_type(8)));
typedef float f32x16 __attribute__((ext_vector_type(16)));
typedef float f32x4 __attribute__((ext_vector_type(4)));
#define MFMA32(a, b, c) __builtin_amdgcn_mfma_f32_32x32x16_bf16((a), (b), (c), 0, 0, 0)

constexpr int NWAVES = 8, NTHREADS = 512;
constexpr int LDS_GEMM = 131072;
constexpr int LDS_MISC = LDS_GEMM;
constexpr int LDS_BYTES = 147456;
constexpr int CW_BAR = 4096;
constexpr int NPHASE = 19;
#ifndef F8_LAYERS
#define F8_LAYERS 3
#endif
constexpr int F8_WUP_SH = 4, F8_WDN_SH = 5;
DI unsigned cvt4_fp8(float a, float b, float c, float d) {
    a = fminf(fmaxf(a, -448.f), 448.f); b = fminf(fmaxf(b, -448.f), 448.f); c = fminf(fmaxf(c, -448.f), 448.f); d = fminf(fmaxf(d, -448.f), 448.f);
    unsigned w = 0; w = __builtin_amdgcn_cvt_pk_fp8_f32(a, b, w, false); w = __builtin_amdgcn_cvt_pk_fp8_f32(c, d, w, true); return w; }

struct MArgs { const float* in[21]; float* out; unsigned char* ws; int ph_lo, ph_hi; };

DI unsigned pk2bf(float lo, float hi) { return pg8::cvt_pk_bf16(lo, hi); }
DI float fast_sigmoid(float x) { return __builtin_amdgcn_rcpf(1.f + __builtin_amdgcn_exp2f(-LOG2E * x)); }

constexpr int TP_PITCH = 72;
DI void transpose_item(const float* W, int K, int N, int k0, int n0, bf16_t* dst  , LAS bf16_t* T, int lane) {
    const int kr = lane >> 4, nc = lane & 15;
    f32x4 v[16];
#pragma unroll
    for (int it = 0; it < 16; ++it) v[it] = *(const f32x4*)(W + (size_t)(k0 + 4 * it + kr) * N + n0 + 4 * nc);
#pragma unroll
    for (int it = 0; it < 16; ++it) { const int k = 4 * it + kr;
        T[(4 * nc + 0) * TP_PITCH + k] = f2bf(v[it].x); T[(4 * nc + 1) * TP_PITCH + k] = f2bf(v[it].y); T[(4 * nc + 2) * TP_PITCH + k] = f2bf(v[it].z); T[(4 * nc + 3) * TP_PITCH + k] = f2bf(v[it].w); }
    asm volatile("s_waitcnt lgkmcnt(0)" ::: "memory");
    const int nr = lane >> 3, kc = lane & 7;
#pragma unroll
    for (int it = 0; it < 8; ++it) {
        const int n = 8 * it + nr;
        const u32x4_t o = *(const LAS u32x4_t*)(T + n * TP_PITCH + 8 * kc);
        *(u32x4_t*)(dst + (size_t)n * K + k0 + 8 * kc) = o;
    }
    asm volatile("s_waitcnt lgkmcnt(0)" ::: "memory");
}
constexpr int TP8_PITCH = 80;
DI void transpose_item_f8(const float* W, int N, int k0, int n0, unsigned char* dst  , LAS unsigned char* T, int lane, float scale) {
    const int kr = lane >> 4, nc = lane & 15;
    f32x4 v[16];
#pragma unroll
    for (int it = 0; it < 16; ++it) v[it] = *(const f32x4*)(W + (size_t)(k0 + 16 * kr + it) * N + n0 + 4 * nc) * scale;
#pragma unroll
    for (int q = 0; q < 4; ++q)
#pragma unroll
        for (int c = 0; c < 4; ++c) *(LAS unsigned*)(T + (4 * nc + c) * TP8_PITCH + 16 * kr + 4 * q) = cvt4_fp8(v[4 * q][c], v[4 * q + 1][c], v[4 * q + 2][c], v[4 * q + 3][c]);
    asm volatile("s_waitcnt lgkmcnt(0)" ::: "memory");
    const int nr = lane >> 2, kc = lane & 3;
#pragma unroll
    for (int it = 0; it < 4; ++it) { const int n = 16 * it + nr; const u32x4_t o = *(const LAS u32x4_t*)(T + n * TP8_PITCH + 16 * kc); *(u32x4_t*)(dst + (size_t)n * 1024 + k0 + 16 * kc) = o; }
    asm volatile("s_waitcnt lgkmcnt(0)" ::: "memory");
}
DI int win_row(int n0) {
    if (n0 < 512) return n0;
    if (n0 < 640) return 5632 + (n0 - 512);
    if (n0 < 768) return 5888 + (n0 - 640);
    if (n0 < 1280) return 512 + (n0 - 768);
    if (n0 < 1792) return 1024 + (n0 - 1280);
    if (n0 < 2304) return 5888 + 128 + (n0 - 1792);
    if (n0 < 2816) return 1536 + (n0 - 2304);
    if (n0 < 3328) return 2048 + (n0 - 2816);
    if (n0 < 3840) return 5888 + 640 + (n0 - 3328);
    return 2560 + (n0 - 3840);
}
DI void prologue_phase(const MArgs& A, LAS unsigned char* lds, int gw, int ngw, int wave, int lane) {
    LAS bf16_t* T = (LAS bf16_t*)(lds + wave * 16384);
    constexpr int I_IN = 16 * 108, I_OUT = 16 * 16, I_BR = 3 * 8 * 16, I_UP = 32 * 16 * 32, I_DN = 32 * 16 * 16, I_L = I_IN + I_OUT + I_BR + I_UP + I_DN;
    for (int it = gw; it < 2 * I_L; it += ngw) {
        const int l = it / I_L; int r = it % I_L;
        unsigned char* wl = A.ws + WS_W + (size_t)l * WL_BYTES;
        if (r < I_IN) { const int kb = r / 108, nb = r % 108; const float* W = A.in[1] + (size_t)l * DM * IN_W;
            transpose_item(W, DM, IN_W, 64 * kb, 64 * nb, (bf16_t*)(wl + WL_IN) + (size_t)win_row(64 * nb) * DM, T, lane); continue; }
        r -= I_IN;
        if (r < I_OUT) { const int kb = r / 16, nb = r % 16; const float* W = A.in[10] + (size_t)l * DM * DM;
            transpose_item(W, DM, DM, 64 * kb, 64 * nb, (bf16_t*)(wl + WL_OUT) + (size_t)(64 * nb) * DM, T, lane); continue; }
        r -= I_OUT;
        if (r < I_BR) { const int i = r / 128, q = r % 128, kb = q / 16, nb = q % 16; const float* W = A.in[9] + ((size_t)l * 3 + i) * 512 * DM;
            transpose_item(W, 512, DM, 64 * kb, 64 * nb, (bf16_t*)(wl + WL_BR) + (size_t)(i * 1024 + 64 * nb) * 512, T, lane); continue; }
        r -= I_BR;
        if (r < I_UP) { const int e = r / 512, q = r % 512, kb = q / 32, nb = q % 32; const float* W = A.in[15] + ((size_t)l * NE + e) * DM * 2048;
            const int n0 = 64 * nb, nn = n0 & 1023, row = (nn >> 7) * 256 + (n0 >= 1024 ? 128 : 0) + (nn & 127);
            if ((F8_LAYERS >> l) & 1) transpose_item_f8(W, 2048, 64 * kb, n0, wl + WL_UP + (size_t)(e * 2048 + row) * 1024, (LAS unsigned char*)T, lane, (float)(1 << F8_WUP_SH));
            else transpose_item(W, DM, 2048, 64 * kb, n0, (bf16_t*)(wl + WL_UP) + (size_t)(e * 2048 + row) * DM, T, lane);
            continue; }
        r -= I_UP;
        { const int e = r / 256, q = r % 256, kb = q / 16, nb = q % 16; const float* W = A.in[17] + ((size_t)l * NE + e) * FE * DM;
            if ((F8_LAYERS >> l) & 1) transpose_item_f8(W, DM, 64 * kb, 64 * nb, wl + WL_DN + (size_t)(e * 1024 + 64 * nb) * 1024, (LAS unsigned char*)T, lane, (float)(1 << F8_WDN_SH));
            else transpose_item(W, FE, DM, 64 * kb, 64 * nb, (bf16_t*)(wl + WL_DN) + (size_t)(e * 1024 + 64 * nb) * FE, T, lane); }
    }
    for (int m = gw; m < NTOK; m += ngw) {
        const float* xr = A.in[0] + (size_t)m * DM; bf16_t* o = (bf16_t*)(A.ws + WS_XB) + (size_t)m * DM;
#pragma unroll
        for (int j = 0; j < 4; ++j) { const f32x4 v = *(const f32x4*)(xr + 256 * j + 4 * lane); uint2 pk; pk.x = pk2bf(v.x, v.y); pk.y = pk2bf(v.z, v.w); *(uint2*)(o + 256 * j + 4 * lane) = pk; }
    }
}

struct SchedInProj {
    pg8::StaticOrder so; int xb0, w0;
    DI bool next(int i, pg8::Unit& u) const { pg8::Unit v; if (!so.next(i, v)) return false;
        if (v.pn < 23) { u.pm = xb0 + v.pm; u.pn = w0 + v.pn; } else { u.pm = w0 + v.pn; u.pn = xb0 + v.pm; } return true; }
    DI void a_ready(const pg8::Unit&) const {}
    DI void done(const pg8::Unit&) const {}
};
struct SchedBranch {
    int c, G, a0, b0;
    DI bool next(int i, pg8::Unit& u) const { const int p = c + (i / 3) * G; if (p >= 256) return false; const int br = i % 3; u.pm = a0 + br * 64 + (p >> 2); u.pn = b0 + br * 4 + (p & 3); return true; }
    DI void a_ready(const pg8::Unit&) const {}
    DI void done(const pg8::Unit&) const {}
};
struct SchedPlain {
    pg8::StaticOrder so; int a0, b0;
    DI bool next(int i, pg8::Unit& u) const { pg8::Unit v; if (!so.next(i, v)) return false; u.pm = a0 + v.pm; u.pn = b0 + v.pn; return true; }
    DI void a_ready(const pg8::Unit&) const {}
    DI void done(const pg8::Unit&) const {}
};
struct SchedMoe {
    const int* pane; int NJ, a0, b0, G, c, nunits;
    DI bool next(int i, pg8::Unit& u) const {
        const long L = (long)i * G + c; if (L >= nunits) return false;
        int id = (int)L; { const int q = nunits / 8, r = nunits % 8, x = id % 8, off = id / 8; id = (x < r ? x * (q + 1) : r * (q + 1) + (x - r) * q) + off; }
        const int p = id / NJ, j = id % NJ; const int e = __builtin_amdgcn_readfirstlane(pane[p]);
        u.pm = a0 + p; u.pn = b0 + e * NJ + j; return true; }
    DI void a_ready(const pg8::Unit&) const {}
    DI void done(const pg8::Unit&) const {}
};

struct EpiInProj {
    static constexpr bool PERM = true, AFTER_DRAIN = false;
    unsigned char* ws; int xb0, w0;
    DI void operator()(const f32x4 (&acc)[2][2][4][2], const pg8::Unit& u, int wr, int wc, int fr, int fq) const {
        { unsigned o1_ = ~0u; asm volatile("" : "+s"(o1_)); const int ln_ = (int)__builtin_amdgcn_mbcnt_hi(o1_, __builtin_amdgcn_mbcnt_lo(o1_, 0u)); fr = ln_ & 15; fq = ln_ >> 4; }
        const int r0 = wr * 64 + fr, c0 = wc * 32 + 8 * fq;
        if (u.pm >= xb0) {
            const int t = u.pn - w0, tok0 = (u.pm - xb0) * 256;
            bf16_t* base; int ld, colb; float sc = 1.f; bool sig = false; int nbj = 2;
            if (t < 2) { base = (bf16_t*)(ws + WS_QA); ld = 512; colb = 256 * t; sc = C2; }
            else if (t < 4) { base = (bf16_t*)(ws + WS_QB); ld = 512; colb = 256 * (t - 2); sc = C2; }
            else if (t < 6) { base = (bf16_t*)(ws + WS_KB); ld = 512; colb = 256 * (t - 4); }
            else if (t < 8) { base = (bf16_t*)(ws + WS_QC); ld = 512; colb = 256 * (t - 6); sc = C2; }
            else if (t < 10) { base = (bf16_t*)(ws + WS_KC); ld = 512; colb = 256 * (t - 8); }
            else if (t < 22) { base = (bf16_t*)(ws + WS_G); ld = 3072; colb = 256 * (t - 10); sig = true; }
            else { base = (bf16_t*)(ws + WS_KA); ld = 128; colb = 0; nbj = 1; }
#pragma unroll
            for (int ai = 0; ai < 2; ++ai)
#pragma unroll
                for (int m = 0; m < 4; ++m) { bf16_t* rowp = base + (size_t)(tok0 + r0 + ai * 128 + m * 16) * ld + colb + c0;
#pragma unroll
                    for (int bj = 0; bj < 2; ++bj) { if (bj < nbj) { f32x4 v0 = acc[ai][bj][m][0] * sc, v1 = acc[ai][bj][m][1] * sc;
                        if (sig) { v0 = (f32x4){fast_sigmoid(v0.x), fast_sigmoid(v0.y), fast_sigmoid(v0.z), fast_sigmoid(v0.w)}; v1 = (f32x4){fast_sigmoid(v1.x), fast_sigmoid(v1.y), fast_sigmoid(v1.z), fast_sigmoid(v1.w)}; }
                        u32x4_t w; w.x = pk2bf(v0.x, v0.y); w.y = pk2bf(v0.z, v0.w); w.z = pk2bf(v1.x, v1.y); w.w = pk2bf(v1.z, v1.w);
                        *(u32x4_t*)(rowp + bj * 128) = w; } } }
        } else {
            const int ch0 = (u.pm - w0 - 23) * 256, tok0 = (u.pn - xb0) * 256; bf16_t* VT = (bf16_t*)(ws + WS_VT);
#pragma unroll
            for (int ai = 0; ai < 2; ++ai)
#pragma unroll
                for (int m = 0; m < 4; ++m) { bf16_t* rowp = VT + (size_t)(ch0 + r0 + ai * 128 + m * 16) * NTOK + tok0 + c0;
#pragma unroll
                    for (int bj = 0; bj < 2; ++bj) { const f32x4 v0 = acc[ai][bj][m][0], v1 = acc[ai][bj][m][1];
                        u32x4_t w; w.x = pk2bf(v0.x, v0.y); w.y = pk2bf(v0.z, v0.w); w.z = pk2bf(v1.x, v1.y); w.w = pk2bf(v1.z, v1.w);
                        *(u32x4_t*)(rowp + bj * 128) = w; } }
        }
    }
};
struct EpiBranch {
    static constexpr bool PERM = true, AFTER_DRAIN = false;
    unsigned char* ws; int a0, b0;
    DI void operator()(const f32x4 (&acc)[2][2][4][2], const pg8::Unit& u, int wr, int wc, int fr, int fq) const {
        { unsigned o1_ = ~0u; asm volatile("" : "+s"(o1_)); const int ln_ = (int)__builtin_amdgcn_mbcnt_hi(o1_, __builtin_amdgcn_mbcnt_lo(o1_, 0u)); fr = ln_ & 15; fq = ln_ >> 4; }
        const int i = (u.pn - b0) >> 2, pn = (u.pn - b0) & 3, pm = (u.pm - a0) & 63;
        const bf16_t* G = (const bf16_t*)(ws + WS_G); bf16_t* MB = (bf16_t*)(ws + WS_MB);
        const int r0 = pm * 256 + wr * 64 + fr, c0 = pn * 256 + wc * 32 + 8 * fq;
#pragma unroll
        for (int ai = 0; ai < 2; ++ai)
#pragma unroll
            for (int m = 0; m < 4; ++m) { const size_t row = (size_t)(r0 + ai * 128 + m * 16);
#pragma unroll
                for (int bj = 0; bj < 2; ++bj) { const int col = c0 + bj * 128;
                    const u32x4_t gw = *(const u32x4_t*)(G + row * 3072 + i * 1024 + col);
                    f32x4 v0, v1;
                    v0.x = __uint_as_float(gw.x << 16) * acc[ai][bj][m][0].x; v0.y = __uint_as_float(gw.x & 0xffff0000u) * acc[ai][bj][m][0].y;
                    v0.z = __uint_as_float(gw.y << 16) * acc[ai][bj][m][0].z; v0.w = __uint_as_float(gw.y & 0xffff0000u) * acc[ai][bj][m][0].w;
                    v1.x = __uint_as_float(gw.z << 16) * acc[ai][bj][m][1].x; v1.y = __uint_as_float(gw.z & 0xffff0000u) * acc[ai][bj][m][1].y;
                    v1.z = __uint_as_float(gw.w << 16) * acc[ai][bj][m][1].z; v1.w = __uint_as_float(gw.w & 0xffff0000u) * acc[ai][bj][m][1].w;
                    bf16_t* mp = MB + row * DM + col;
                    if (i > 0) { const u32x4_t pw = *(const u32x4_t*)mp;
                        v0.x += __uint_as_float(pw.x << 16); v0.y += __uint_as_float(pw.x & 0xffff0000u); v0.z += __uint_as_float(pw.y << 16); v0.w += __uint_as_float(pw.y & 0xffff0000u);
                        v1.x += __uint_as_float(pw.z << 16); v1.y += __uint_as_float(pw.z & 0xffff0000u); v1.z += __uint_as_float(pw.w << 16); v1.w += __uint_as_float(pw.w & 0xffff0000u); }
                    u32x4_t w; w.x = pk2bf(v0.x, v0.y); w.y = pk2bf(v0.z, v0.w); w.z = pk2bf(v1.x, v1.y); w.w = pk2bf(v1.z, v1.w); *(u32x4_t*)mp = w; } }
    }
};
struct EpiWout {
    static constexpr bool PERM = false, AFTER_DRAIN = false;
    const float* x; float* Y; int a0, b0;
    DI void operator()(const f32x4 (&acc)[2][2][4][2], const pg8::Unit& u, int wr, int wc, int fr, int fq) const {
        { unsigned o1_ = ~0u; asm volatile("" : "+s"(o1_)); const int ln_ = (int)__builtin_amdgcn_mbcnt_hi(o1_, __builtin_amdgcn_mbcnt_lo(o1_, 0u)); fr = ln_ & 15; fq = ln_ >> 4; }
        const int r0 = (u.pm - a0) * 256 + wr * 64 + fr, c0 = (u.pn - b0) * 256 + wc * 32 + 4 * fq;
#pragma unroll
        for (int ai = 0; ai < 2; ++ai)
#pragma unroll
            for (int m = 0; m < 4; ++m) { const size_t ro = (size_t)(r0 + ai * 128 + m * 16) * DM + c0;
#pragma unroll
                for (int bj = 0; bj < 2; ++bj)
#pragma unroll
                    for (int n = 0; n < 2; ++n) { const size_t o = ro + bj * 128 + n * 16; *(f32x4*)(Y + o) = *(const f32x4*)(x + o) * DN_ALPHA + acc[ai][bj][m][n]; } }
    }
};
template <bool F8> struct EpiUp {
    static constexpr bool PERM = true, AFTER_DRAIN = false;
    unsigned char* ws; const float* b_up; int a0, b0;
    DI void operator()(const f32x4 (&acc)[2][2][4][2], const pg8::Unit& u, int wr, int wc, int fr, int fq) const {
        { unsigned o1_ = ~0u; asm volatile("" : "+s"(o1_)); const int ln_ = (int)__builtin_amdgcn_mbcnt_hi(o1_, __builtin_amdgcn_mbcnt_lo(o1_, 0u)); fr = ln_ & 15; fq = ln_ >> 4; }
        const int t = u.pn - b0, e = t >> 3, j = t & 7; bf16_t* ACT = (bf16_t*)(ws + WS_ACTB);
        const int r0 = (u.pm - a0) * 256 + wr * 64 + fr, c0 = j * 128 + wc * 32 + 8 * fq;
        f32x4 bg[2], bl[2];
#pragma unroll
        for (int n = 0; n < 2; ++n) { bg[n] = *(const f32x4*)(b_up + e * 2048 + c0 + 4 * n); bl[n] = *(const f32x4*)(b_up + e * 2048 + 1024 + c0 + 4 * n) + 1.f; }
#pragma unroll
        for (int ai = 0; ai < 2; ++ai)
#pragma unroll
            for (int m = 0; m < 4; ++m) { float o[8];
#pragma unroll
                for (int n = 0; n < 2; ++n)
#pragma unroll
                    for (int q = 0; q < 4; ++q) { float hg = acc[ai][0][m][n][q] + bg[n][q], hl = acc[ai][1][m][n][q] + bl[n][q];
                        hg = fminf(hg, SWI_LIMIT); hl = fminf(fmaxf(hl, 1.f - SWI_LIMIT), 1.f + SWI_LIMIT);
                        o[4 * n + q] = hg * fast_sigmoid(SWI_ALPHA * hg) * hl; }
                if constexpr (F8) { uint2 w; w.x = cvt4_fp8(o[0], o[1], o[2], o[3]); w.y = cvt4_fp8(o[4], o[5], o[6], o[7]); *(uint2*)((unsigned char*)ACT + (size_t)(r0 + ai * 128 + m * 16) * 1024 + c0) = w; }
                else { u32x4_t w; w.x = pk2bf(o[0], o[1]); w.y = pk2bf(o[2], o[3]); w.z = pk2bf(o[4], o[5]); w.w = pk2bf(o[6], o[7]);
                    *(u32x4_t*)(ACT + (size_t)(r0 + ai * 128 + m * 16) * FE + c0) = w; } }
    }
};
struct EpiDown {
    static constexpr bool PERM = true, AFTER_DRAIN = false;
    unsigned char* ws; const float* b_dn; int a0, b0;
    DI void operator()(const f32x4 (&acc)[2][2][4][2], const pg8::Unit& u, int wr, int wc, int fr, int fq) const {
        { unsigned o1_ = ~0u; asm volatile("" : "+s"(o1_)); const int ln_ = (int)__builtin_amdgcn_mbcnt_hi(o1_, __builtin_amdgcn_mbcnt_lo(o1_, 0u)); fr = ln_ & 15; fq = ln_ >> 4; }
        const int t = u.pn - b0, e = t >> 2, j = t & 3; bf16_t* YS = (bf16_t*)(ws + WS_YS); const float* rw = (const float*)(ws + WS_RW);
        const int r0 = (u.pm - a0) * 256 + wr * 64 + fr, c0 = j * 256 + wc * 32 + 8 * fq;
        f32x4 bv[2][2];
#pragma unroll
        for (int bj = 0; bj < 2; ++bj)
#pragma unroll
            for (int n = 0; n < 2; ++n) bv[bj][n] = *(const f32x4*)(b_dn + e * DM + c0 + bj * 128 + 4 * n);
#pragma unroll
        for (int ai = 0; ai < 2; ++ai)
#pragma unroll
            for (int m = 0; m < 4; ++m) { const int row = r0 + ai * 128 + m * 16; const float w8 = rw[row];
#pragma unroll
                for (int bj = 0; bj < 2; ++bj) { const f32x4 v0 = (acc[ai][bj][m][0] + bv[bj][0]) * w8, v1 = (acc[ai][bj][m][1] + bv[bj][1]) * w8;
                    u32x4_t w; w.x = pk2bf(v0.x, v0.y); w.y = pk2bf(v0.z, v0.w); w.z = pk2bf(v1.x, v1.y); w.w = pk2bf(v1.z, v1.w);
                    *(u32x4_t*)(YS + (size_t)row * DM + c0 + bj * 128) = w; } }
    }
};

DI int kperm(int r) { return (r & 16) + 8 * ((r >> 2) & 1) + 4 * ((r >> 3) & 1) + (r & 3); }
DI float half_max(float v) { auto rr = __builtin_amdgcn_permlane32_swap(__float_as_uint(v), __float_as_uint(v), false, false); return fmaxf(__uint_as_float(rr[0]), __uint_as_float(rr[1])); }
DI float half_sum(float v) { auto rr = __builtin_amdgcn_permlane32_swap(__float_as_uint(v), __float_as_uint(v), false, false); return __uint_as_float(rr[0]) + __uint_as_float(rr[1]); }
constexpr float ATT_THR = 24.f;
struct SoftState { float m, l; };
DI bf16x8 pack8(const f32x16& s, int st) {
    u32x4_t p; p.x = pk2bf(s[8 * st + 0], s[8 * st + 1]); p.y = pk2bf(s[8 * st + 2], s[8 * st + 3]); p.z = pk2bf(s[8 * st + 4], s[8 * st + 5]); p.w = pk2bf(s[8 * st + 6], s[8 * st + 7]);
    return __builtin_bit_cast(bf16x8, p);
}
DI f32x16 qk_tile(const bf16_t* krow  , const bf16x8 (&qf)[4]) {
    f32x16 s = {0.f, 0.f, 0.f, 0.f, 0.f, 0.f, 0.f, 0.f, 0.f, 0.f, 0.f, 0.f, 0.f, 0.f, 0.f, 0.f};
#pragma unroll
    for (int st = 0; st < 4; ++st) { const bf16x8 kf = *(const bf16x8*)(krow + 16 * st); s = MFMA32(kf, qf[st], s); }
    return s;
}
template <int NB> DI void soft_tile(f32x16& s, SoftState& st, f32x16 (&o)[NB]) {
    float mx = s[0];
#pragma unroll
    for (int r = 1; r < 16; ++r) mx = fmaxf(mx, s[r]);
    mx = half_max(mx);
    if (__any(mx > st.m + ATT_THR)) {
        const float mn = fmaxf(st.m, mx), f = __builtin_amdgcn_exp2f(st.m - mn);
        st.m = mn; st.l *= f;
#pragma unroll
        for (int b = 0; b < NB; ++b)
#pragma unroll
            for (int r = 0; r < 16; ++r) o[b][r] *= f;
    }
    float sum = 0.f;
#pragma unroll
    for (int r = 0; r < 16; ++r) { s[r] = __builtin_amdgcn_exp2f(s[r] - st.m); sum += s[r]; }
    st.l += sum;
}
DI void load_qf(bf16x8 (&qf)[4], const bf16_t* qrow  ) {
#pragma unroll
    for (int st = 0; st < 4; ++st) qf[st] = *(const bf16x8*)(qrow + 16 * st);
}
template <int NB> DI void zero_o(f32x16 (&o)[NB]) {
#pragma unroll
    for (int b = 0; b < NB; ++b)
#pragma unroll
        for (int r = 0; r < 16; ++r) o[b][r] = 0.f;
}
template <int NB> DI void pv_tile(f32x16 (&o)[NB], const bf16_t* vt, const bf16x8& p0, const bf16x8& p1) {
#pragma unroll
    for (int b = 0; b < NB; ++b) {
        const bf16x8 v0 = *(const bf16x8*)(vt + (size_t)(32 * b) * NTOK), v1 = *(const bf16x8*)(vt + (size_t)(32 * b) * NTOK + 16);
        o[b] = MFMA32(v0, p0, o[b]); o[b] = MFMA32(v1, p1, o[b]);
    }
}
template <int NB> DI void store_o(const f32x16 (&o)[NB], bf16_t* orow  , int h) {
#pragma unroll
    for (int b = 0; b < NB; ++b)
#pragma unroll
        for (int g = 0; g < 4; ++g) { uint2 pk; pk.x = pk2bf(o[b][4 * g], o[b][4 * g + 1]); pk.y = pk2bf(o[b][4 * g + 2], o[b][4 * g + 3]); *(uint2*)(orow + 32 * b + 8 * g + 4 * h) = pk; }
}

DI void attn_a_task(const MArgs& A, int l, int task, int lane) {
    asm volatile("" : "+v"(lane));
    const int r = lane & 31, h = lane >> 5; const int qt = task & 63, hd = (task >> 6) & 7, b = task >> 9, g = hd >> 2;
    const int q0 = qt * 32, qpos = q0 + r; const size_t tb = (size_t)b * SEQ;
    const bf16_t* QA = (const bf16_t*)(A.ws + WS_QA); const bf16_t* KA = (const bf16_t*)(A.ws + WS_KA); const bf16_t* VT = (const bf16_t*)(A.ws + WS_VT);
    bf16x8 qf[4]; load_qf(qf, QA + (tb + qpos) * 512 + hd * 64 + 8 * h);
    const float slope = exp2f(-8.f * (float)(hd + 1) / 12.f) * LOG2E, sk = A.in[2][l * 8 + hd] * LOG2E;
    f32x16 o[2]; zero_o<2>(o); SoftState st{-1e30f, 0.f};
    const int kp = kperm(r);
    for (int t = 0; t < 9; ++t) {
        const int k0 = q0 - 128 + 32 * t; if (k0 < 0 || k0 >= SEQ) continue;
        f32x16 s = qk_tile(KA + (tb + k0 + kp) * 128 + g * 64 + 8 * h, qf);
#pragma unroll
        for (int reg = 0; reg < 16; ++reg) { const int kpos = k0 + 16 * (reg >> 3) + 8 * h + (reg & 7); const int d = kpos - qpos; const int ad = d < 0 ? -d : d;
            s[reg] = ad <= 128 ? s[reg] - slope * (float)ad : -INFINITY; }
        soft_tile<2>(s, st, o);
        pv_tile<2>(o, VT + (size_t)(g * 64 + r) * NTOK + tb + k0 + 8 * h, pack8(s, 0), pack8(s, 1));
    }
    float lsum = half_sum(st.l); lsum += __builtin_amdgcn_exp2f(sk - st.m);
    const float rl = 1.f / lsum;
#pragma unroll
    for (int bb = 0; bb < 2; ++bb)
#pragma unroll
        for (int reg = 0; reg < 16; ++reg) o[bb][reg] *= rl;
    store_o<2>(o, (bf16_t*)(A.ws + WS_BR) + (tb + qpos) * 512 + hd * 64, h);
}
DI void attn_c_task(const MArgs& A, int l, int task, int lane, LAS float* tbl  ) {
    asm volatile("" : "+v"(lane));
    const int r = lane & 31, h = lane >> 5; const int j = task & 3, rp = (task >> 2) & 15, hd = (task >> 6) & 7, b = task >> 9;
    const int qrow = 2 * rp + (r >> 4), qc = 16 * j + (r & 15), qpos = qrow * 64 + qc; const size_t tb = (size_t)b * SEQ;
    const int c0 = j == 0 ? 0 : (j == 1 ? 8 : (j == 2 ? 24 : 32));
    const int rsq = min(max(qrow - 4, 0), 24), cs = min(max(qc - 8, 0), 48), lo = cs - c0;
    const int rs0 = min(max(2 * rp - 4, 0), 24), rs1 = min(max(2 * rp - 3, 0), 24);
    const bf16_t* QC = (const bf16_t*)(A.ws + WS_QC); const bf16_t* KC = (const bf16_t*)(A.ws + WS_KC); const bf16_t* VT = (const bf16_t*)(A.ws + WS_VT);
    const float* rpb = A.in[8] + ((size_t)l * 8 + hd) * 15 * 31;
#pragma unroll
    for (int k = 0; k < 8; ++k) { const int i = lane + 64 * k; if (i < 465) tbl[128 + i] = rpb[i] * LOG2E; }
    bf16x8 qf[4]; load_qf(qf, QC + (tb + qpos) * 512 + hd * 64 + 8 * h);
    f32x16 o[2]; zero_o<2>(o); SoftState st{-1e30f, 0.f};
    const int kp = kperm(r);
    for (int kr = rs0; kr < rs1 + 8; ++kr) {
        const int k0 = kr * 64 + c0;
        f32x16 s = qk_tile(KC + (tb + k0 + kp) * 512 + hd * 64 + 8 * h, qf);
        const bool rowok = kr >= rsq && kr < rsq + 8;
        const LAS float* bp = tbl + 128 + (kr - qrow + 7) * 31 + (c0 - qc + 15) + 8 * h;
#pragma unroll
        for (int reg = 0; reg < 16; ++reg) { const int ko = 16 * (reg >> 3) + (reg & 7); const int kof = ko + 8 * h; const bool ok = rowok && kof >= lo && kof < lo + 16;
            const float bias = bp[ko]; s[reg] = ok ? s[reg] + bias : -INFINITY; }
        soft_tile<2>(s, st, o);
        pv_tile<2>(o, VT + (size_t)(640 + hd * 64 + r) * NTOK + tb + k0 + 8 * h, pack8(s, 0), pack8(s, 1));
    }
    const float l_ = half_sum(st.l); const float rl = 1.f / l_;
#pragma unroll
    for (int bb = 0; bb < 2; ++bb)
#pragma unroll
        for (int reg = 0; reg < 16; ++reg) o[bb][reg] *= rl;
    store_o<2>(o, (bf16_t*)(A.ws + WS_BR) + (size_t)2 * NTOK * 512 + (tb + qpos) * 512 + hd * 64, h);
}
DI void attn_b_task(const MArgs& A, int l, int task, int lane) {
    asm volatile("" : "+v"(lane));
    const int r = lane & 31, h = lane >> 5; const int qt = task & 63, hd = (task >> 6) & 3, b = task >> 8;
    const int q0 = qt * 32, qpos = q0 + r; const size_t tb = (size_t)b * SEQ;
    const bf16_t* QB = (const bf16_t*)(A.ws + WS_QB); const bf16_t* KB = (const bf16_t*)(A.ws + WS_KB); const bf16_t* VT = (const bf16_t*)(A.ws + WS_VT);
    const float lam_init = 0.8f - 0.6f * __expf(-0.3f * (float)l);
    const float lam = __expf(wave_sum(A.in[3][l * 64 + lane] * A.in[4][l * 64 + lane])) - __expf(wave_sum(A.in[5][l * 64 + lane] * A.in[6][l * 64 + lane])) + lam_init;
    const float slope = exp2f(-8.f * (float)(8 + hd + 1) / 12.f) * LOG2E;
    bf16x8 q1[4], q2[4]; load_qf(q1, QB + (tb + qpos) * 512 + hd * 128 + 8 * h); load_qf(q2, QB + (tb + qpos) * 512 + hd * 128 + 64 + 8 * h);
    f32x16 o1[4], o2[4]; zero_o<4>(o1); zero_o<4>(o2); SoftState s1{-1e30f, 0.f}, s2{-1e30f, 0.f};
    const int kp = kperm(r);
    const bf16_t* kbase = KB + (tb + kp) * 512 + hd * 128 + 8 * h; const bf16_t* vbase = VT + (size_t)(128 + hd * 128 + r) * NTOK + tb + 8 * h;
    for (int t = 0; t < 64; ++t) {
        const int k0 = 32 * t; const float dbase = (float)(k0 + 8 * h - qpos);
        f32x16 sa = qk_tile(kbase + (size_t)k0 * 512, q1);
#pragma unroll
        for (int reg = 0; reg < 16; ++reg) sa[reg] -= slope * fabsf(dbase + (float)(16 * (reg >> 3) + (reg & 7)));
        soft_tile<4>(sa, s1, o1);
        const bf16x8 pa0 = pack8(sa, 0), pa1 = pack8(sa, 1);
        f32x16 sb = qk_tile(kbase + (size_t)k0 * 512 + 64, q2);
#pragma unroll
        for (int reg = 0; reg < 16; ++reg) sb[reg] -= slope * fabsf(dbase + (float)(16 * (reg >> 3) + (reg & 7)));
        soft_tile<4>(sb, s2, o2);
        const bf16x8 pb0 = pack8(sb, 0), pb1 = pack8(sb, 1);
#pragma unroll
        for (int bb = 0; bb < 4; ++bb) {
            const bf16x8 v0 = *(const bf16x8*)(vbase + (size_t)(32 * bb) * NTOK + k0), v1 = *(const bf16x8*)(vbase + (size_t)(32 * bb) * NTOK + k0 + 16);
            o1[bb] = MFMA32(v0, pa0, o1[bb]); o1[bb] = MFMA32(v1, pa1, o1[bb]);
            o2[bb] = MFMA32(v0, pb0, o2[bb]); o2[bb] = MFMA32(v1, pb1, o2[bb]);
        }
    }
    const float r1 = 1.f / (s1.l + __shfl_xor(s1.l, 32)), r2 = lam / (s2.l + __shfl_xor(s2.l, 32));
    float ssq = 0.f;
#pragma unroll
    for (int bb = 0; bb < 4; ++bb)
#pragma unroll
        for (int reg = 0; reg < 16; ++reg) { const float v = o1[bb][reg] * r1 - o2[bb][reg] * r2; o1[bb][reg] = v; ssq += v * v; }
    ssq += __shfl_xor(ssq, 32);
    const float rr = rsqrtf(ssq * (1.f / 128.f) + LN_EPS) * (1.f - lam_init);
    const float* gain = A.in[7] + l * 128;
#pragma unroll
    for (int bb = 0; bb < 4; ++bb)
#pragma unroll
        for (int g4 = 0; g4 < 4; ++g4) { const f32x4 gv = *(const f32x4*)(gain + 32 * bb + 8 * g4 + 4 * h);
            o1[bb][4 * g4] *= rr * gv.x; o1[bb][4 * g4 + 1] *= rr * gv.y; o1[bb][4 * g4 + 2] *= rr * gv.z; o1[bb][4 * g4 + 3] *= rr * gv.w; }
    store_o<4>(o1, (bf16_t*)(A.ws + WS_BR) + (size_t)NTOK * 512 + (tb + qpos) * 512 + hd * 128, h);
}

#define XORC(a, CSTR) ({ int r_; asm volatile("v_xor_b32_e32 %0, " CSTR ", %1" : "=v"(r_) : "v"(a)); r_; })
constexpr int AB_KBUF = 0, AB_VBUF = 32768, AB_BUFSZ = 16384;
DI void attn_b_unit(const MArgs& A, int l, int unit, LAS unsigned char* lds, int wave, int lane) {
    asm volatile("" : "+v"(lane));
    const int r = lane & 31, h = lane >> 5; const int qb = unit & 7, hd = (unit >> 3) & 3, b = unit >> 5;
    const int q0 = qb * 256 + wave * 32, qpos = q0 + r; const size_t tb = (size_t)b * SEQ;
    const bf16_t* QB = (const bf16_t*)(A.ws + WS_QB); const bf16_t* KB = (const bf16_t*)(A.ws + WS_KB); const bf16_t* VT = (const bf16_t*)(A.ws + WS_VT);
    const float slope = exp2f(-8.f * (float)(8 + hd + 1) / 12.f) * LOG2E;
    bf16x8 q1[4], q2[4]; load_qf(q1, QB + (tb + qpos) * 512 + hd * 128 + 8 * h); load_qf(q2, QB + (tb + qpos) * 512 + hd * 128 + 64 + 8 * h);
    f32x16 o1[4], o2[4]; zero_o<4>(o1); zero_o<4>(o2); SoftState s1{-1e30f, 0.f}, s2{-1e30f, 0.f};
    const int p0 = wave * 64 + lane, rw0 = p0 >> 4, cs = (p0 & 15) ^ (rw0 & 15);
    const unsigned offK = (unsigned)(rw0 * 512 + 8 * cs) * 2u;
    const unsigned offV = (unsigned)((2 * rw0 + (cs >> 3)) * NTOK + 8 * (cs & 7)) * 2u;
    const unsigned char* kbase_u = (const unsigned char*)(KB + tb * 512 + hd * 128);
    const unsigned char* vbase_u = (const unsigned char*)(VT + (size_t)(128 + hd * 128) * NTOK + tb);
    const int dstoff = wave * 1024;
#define AB_DMA(stage, buf) do { const unsigned char* k_ = kbase_u + (size_t)(stage) * 64 * 512 * 2; const unsigned char* v_ = vbase_u + (stage) * 64 * 2; \
        __builtin_amdgcn_global_load_lds((const unsigned*)(k_ + offK), (LAS unsigned*)(lds + AB_KBUF + (buf) * AB_BUFSZ + dstoff), 16, 0, 0); \
        __builtin_amdgcn_global_load_lds((const unsigned*)(k_ + 32 * 512 * 2 + offK), (LAS unsigned*)(lds + AB_KBUF + (buf) * AB_BUFSZ + dstoff + 8192), 16, 0, 0); \
        __builtin_amdgcn_global_load_lds((const unsigned*)(v_ + offV), (LAS unsigned*)(lds + AB_VBUF + (buf) * AB_BUFSZ + dstoff), 16, 0, 0); \
        __builtin_amdgcn_global_load_lds((const unsigned*)(v_ + (size_t)64 * NTOK * 2 + offV), (LAS unsigned*)(lds + AB_VBUF + (buf) * AB_BUFSZ + dstoff + 8192), 16, 0, 0); } while (0)
    const int key0 = kperm(r);
    const int kaddr = AB_KBUF + key0 * 256 + (((h ^ key0) & 15) << 4);
    const int pr0 = r >> 1;
    const int vaddr = AB_VBUF + pr0 * 256 + ((((8 * (r & 1) + h) ^ pr0) & 15) << 4);
    AB_DMA(0, 0);
    asm volatile("s_waitcnt vmcnt(0)" ::: "memory"); __syncthreads();
    for (int stg = 0; stg < 32; ++stg) {
        const int buf = stg & 1;
        if (stg + 1 < 32) { if (buf) AB_DMA(stg + 1, 0); else AB_DMA(stg + 1, 1); }
        const int kb_ = kaddr + buf * AB_BUFSZ, vb_ = vaddr + buf * AB_BUFSZ;
#define AB_KRD(CSTR, SUB) (*(const LAS bf16x8*)(lds + (XORC(kb_, CSTR) + (SUB) * 8192)))
#define AB_VRD(CSTR, BB) (*(const LAS bf16x8*)(lds + (XORC(vb_, CSTR) + (BB) * 4096)))
#define AB_SUB(SUB, VC0, VC1) do { \
            const float dbase = (float)(stg * 64 + (SUB) * 32 + 8 * h - qpos); \
            f32x16 sa = {0.f, 0.f, 0.f, 0.f, 0.f, 0.f, 0.f, 0.f, 0.f, 0.f, 0.f, 0.f, 0.f, 0.f, 0.f, 0.f}; \
            sa = MFMA32(AB_KRD("0x00", SUB), q1[0], sa); sa = MFMA32(AB_KRD("0x20", SUB), q1[1], sa); sa = MFMA32(AB_KRD("0x40", SUB), q1[2], sa); sa = MFMA32(AB_KRD("0x60", SUB), q1[3], sa); \
            _Pragma("unroll") for (int reg = 0; reg < 16; ++reg) sa[reg] -= slope * fabsf(dbase + (float)(16 * (reg >> 3) + (reg & 7))); \
            __builtin_amdgcn_sched_barrier(0); soft_tile<4>(sa, s1, o1); \
            const bf16x8 pa0 = pack8(sa, 0), pa1 = pack8(sa, 1); __builtin_amdgcn_sched_barrier(0); \
            f32x16 sb = {0.f, 0.f, 0.f, 0.f, 0.f, 0.f, 0.f, 0.f, 0.f, 0.f, 0.f, 0.f, 0.f, 0.f, 0.f, 0.f}; \
            sb = MFMA32(AB_KRD("0x80", SUB), q2[0], sb); sb = MFMA32(AB_KRD("0xa0", SUB), q2[1], sb); sb = MFMA32(AB_KRD("0xc0", SUB), q2[2], sb); sb = MFMA32(AB_KRD("0xe0", SUB), q2[3], sb); \
            _Pragma("unroll") for (int reg = 0; reg < 16; ++reg) sb[reg] -= slope * fabsf(dbase + (float)(16 * (reg >> 3) + (reg & 7))); \
            __builtin_amdgcn_sched_barrier(0); soft_tile<4>(sb, s2, o2); \
            const bf16x8 pb0 = pack8(sb, 0), pb1 = pack8(sb, 1); __builtin_amdgcn_sched_barrier(0); \
            _Pragma("unroll") for (int bb = 0; bb < 4; ++bb) { \
                const bf16x8 v0 = AB_VRD(VC0, bb), v1 = AB_VRD(VC1, bb); \
                o1[bb] = MFMA32(v0, pa0, o1[bb]); o1[bb] = MFMA32(v1, pa1, o1[bb]); \
                o2[bb] = MFMA32(v0, pb0, o2[bb]); o2[bb] = MFMA32(v1, pb1, o2[bb]); if (bb & 1) __builtin_amdgcn_sched_barrier(0); } } while (0)
        AB_SUB(0, "0x00", "0x20");
        AB_SUB(1, "0x40", "0x60");
#undef AB_SUB
#undef AB_KRD
#undef AB_VRD
        asm volatile("s_waitcnt vmcnt(0)" ::: "memory"); __syncthreads();
    }
#undef AB_DMA
    unsigned ones2 = ~0u; asm volatile("" : "+s"(ones2)); const int lane2 = (int)__builtin_amdgcn_mbcnt_hi(ones2, __builtin_amdgcn_mbcnt_lo(ones2, 0u));
    const int r_ = lane2 & 31, h_ = lane2 >> 5;
    const float lam_init = 0.8f - 0.6f * __expf(-0.3f * (float)l);
    float d1 = 0.f, d2 = 0.f;
#pragma unroll 8
    for (int i = 0; i < 64; ++i) { d1 += A.in[3][l * 64 + i] * A.in[4][l * 64 + i]; d2 += A.in[5][l * 64 + i] * A.in[6][l * 64 + i]; }
    const float lam = __expf(d1) - __expf(d2) + lam_init;
    const float r1 = 1.f / half_sum(s1.l), r2 = lam / half_sum(s2.l);
    float ssq = 0.f;
#pragma unroll
    for (int bb = 0; bb < 4; ++bb)
#pragma unroll
        for (int reg = 0; reg < 16; ++reg) { const float v = o1[bb][reg] * r1 - o2[bb][reg] * r2; o1[bb][reg] = v; ssq += v * v; }
    ssq = half_sum(ssq);
    const float rr = rsqrtf(ssq * (1.f / 128.f) + LN_EPS) * (1.f - lam_init);
    const float* gain = A.in[7] + l * 128;
#pragma unroll
    for (int bb = 0; bb < 4; ++bb)
#pragma unroll
        for (int g4 = 0; g4 < 4; ++g4) { const f32x4 gv = *(const f32x4*)(gain + 32 * bb + 8 * g4 + 4 * h_);
            o1[bb][4 * g4] *= rr * gv.x; o1[bb][4 * g4 + 1] *= rr * gv.y; o1[bb][4 * g4 + 2] *= rr * gv.z; o1[bb][4 * g4 + 3] *= rr * gv.w; }
    store_o<4>(o1, (bf16_t*)(A.ws + WS_BR) + (size_t)NTOK * 512 + (tb + qb * 256 + wave * 32 + r_) * 512 + hd * 128, h_);
}

constexpr int AP_KBUF = 0, AP_VBUF = 32768, AP_QBUF = 65536, AP_BUFSZ = 8192;
#define SBAR_() __builtin_amdgcn_sched_barrier(0)
DI void attn_b_unit2(const MArgs& A, int l, int unit, LAS unsigned char* lds, int wave, int lane) {
    asm volatile("" : "+v"(lane));
    const int r = lane & 31, h = lane >> 5; const int qb = unit & 7, hd = (unit >> 3) & 3, b = unit >> 5;
    const int q0 = qb * 256 + wave * 32, qpos = q0 + r; const size_t tb = (size_t)b * SEQ;
    const bf16_t* QB = (const bf16_t*)(A.ws + WS_QB); const bf16_t* KB = (const bf16_t*)(A.ws + WS_KB); const bf16_t* VT = (const bf16_t*)(A.ws + WS_VT);
    const float slope = exp2f(-8.f * (float)(8 + hd + 1) / 12.f) * LOG2E;
    const int ldsb = (int)(unsigned)(uintptr_t)lds;
    const int qoff = ldsb + AP_QBUF + wave * 8192 + lane * 16;
    {   bf16x8 qf[4]; load_qf(qf, QB + (tb + qpos) * 512 + hd * 128 + 8 * h);
#pragma unroll
        for (int st = 0; st < 4; ++st) *(LAS bf16x8*)(LAS unsigned char*)(unsigned)(qoff + st * 1024) = qf[st];
        load_qf(qf, QB + (tb + qpos) * 512 + hd * 128 + 64 + 8 * h);
#pragma unroll
        for (int st = 0; st < 4; ++st) *(LAS bf16x8*)(LAS unsigned char*)(unsigned)(qoff + (4 + st) * 1024) = qf[st]; }
    f32x16 o1[4], o2[4]; zero_o<4>(o1); zero_o<4>(o2); SoftState s1{-1e30f, 0.f}, s2{-1e30f, 0.f};
    const int p0 = wave * 64 + lane, rw0 = p0 >> 4, cs = (p0 & 15) ^ (rw0 & 15);
    const unsigned offK = (unsigned)(rw0 * 512 + 8 * cs) * 2u;
    const unsigned offV = (unsigned)((4 * rw0 + (cs >> 2)) * NTOK + 8 * (cs & 3)) * 2u;
    const unsigned char* kbase_u = (const unsigned char*)(KB + tb * 512 + hd * 128);
    const unsigned char* vbase_u = (const unsigned char*)(VT + (size_t)(128 + hd * 128) * NTOK + tb);
    const int dstoff = wave * 1024;
#define AP_DMA(stage, bufb) do { \
        __builtin_amdgcn_global_load_lds((const unsigned*)(kbase_u + (size_t)(stage) * 32 * 512 * 2 + offK), (LAS unsigned*)(lds + AP_KBUF + (bufb) + dstoff), 16, 0, 0); \
        __builtin_amdgcn_global_load_lds((const unsigned*)(vbase_u + (stage) * 32 * 2 + offV), (LAS unsigned*)(lds + AP_VBUF + (bufb) + dstoff), 16, 0, 0); } while (0)
    const int key0 = kperm(r);
    const int kaddr = ldsb + AP_KBUF + key0 * 256 + (((h ^ key0) & 15) << 4);
    const int pr0 = r >> 2;
    const int vaddr = ldsb + AP_VBUF + pr0 * 256 + ((((4 * (r & 3) + h) ^ pr0) & 15) << 4);
#define AP_P(x) ((const LAS bf16x8*)(LAS unsigned char*)(unsigned)(x))
#define AP_RD(base, CSTR, OFF) (*AP_P(XORC(base, CSTR) + (OFF)))
#define AP_RD0(base, OFF) (*AP_P((base) + (OFF)))
#define AP_RQ(M, ST_) (*AP_P(qoff + (4 * (M) + (ST_)) * 1024))
    AP_DMA(0, 0); AP_DMA(1, AP_BUFSZ);
    asm volatile("s_waitcnt vmcnt(0)" ::: "memory"); __syncthreads();
    f32x16 SA, SB; bf16x8 PA0, PA1, PB0, PB1;
    { const f32x16 z = {0.f, 0.f, 0.f, 0.f, 0.f, 0.f, 0.f, 0.f, 0.f, 0.f, 0.f, 0.f, 0.f, 0.f, 0.f, 0.f};
      SA = MFMA32(AP_RD0(kaddr, 0), AP_RQ(0, 0), z); SA = MFMA32(AP_RD(kaddr, "0x20", 0), AP_RQ(0, 1), SA); SA = MFMA32(AP_RD(kaddr, "0x40", 0), AP_RQ(0, 2), SA); SA = MFMA32(AP_RD(kaddr, "0x60", 0), AP_RQ(0, 3), SA); SB = z;
      PB0 = (bf16x8){0, 0, 0, 0, 0, 0, 0, 0}; PB1 = PB0; PA0 = PB0; PA1 = PB0; }
#define AP_BIAS4(SC, R0, DB) do { _Pragma("unroll") for (int q_ = 0; q_ < 4; ++q_) { const int reg_ = (R0) + q_; SC[reg_] -= slope * fabsf((DB) + (float)(16 * (reg_ >> 3) + (reg_ & 7))); } } while (0)
#define AP_EXP4(SC, R0, M_) do { _Pragma("unroll") for (int q_ = 0; q_ < 4; ++q_) SC[(R0) + q_] = __builtin_amdgcn_exp2f(SC[(R0) + q_] - (M_)); } while (0)
#define AP_ITER(SC, SN, PP0, PP1, PC0, PC1, ST, OM, OP, QM, KB_, KC0, KC1, KC2, KC3, VB_, DB) do { \
        const f32x16 z_ = {0.f, 0.f, 0.f, 0.f, 0.f, 0.f, 0.f, 0.f, 0.f, 0.f, 0.f, 0.f, 0.f, 0.f, 0.f, 0.f}; \
        const float db_ = (DB); \
        bf16x8 ka_ = (KC0[2] == '0' && KC0[3] == '0') ? AP_RD0(KB_, 0) : AP_RD(KB_, KC0, 0), kb_ = AP_RD(KB_, KC1, 0), qa_ = AP_RQ(QM, 0), qb_ = AP_RQ(QM, 1); SBAR_(); \
        SN = MFMA32(ka_, qa_, z_); ka_ = AP_RD(KB_, KC2, 0); qa_ = AP_RQ(QM, 2); AP_BIAS4(SC, 0, db_); SBAR_(); \
        SN = MFMA32(kb_, qb_, SN); kb_ = AP_RD(KB_, KC3, 0); qb_ = AP_RQ(QM, 3); AP_BIAS4(SC, 4, db_); SBAR_(); \
        bf16x8 va_ = AP_RD0(VB_, 0), vb_ = AP_RD(VB_, "0x20", 0); \
        SN = MFMA32(ka_, qa_, SN); AP_BIAS4(SC, 8, db_); SBAR_(); \
        SN = MFMA32(kb_, qb_, SN); AP_BIAS4(SC, 12, db_); SBAR_(); \
        OP[0] = MFMA32(va_, PP0, OP[0]); va_ = AP_RD(VB_, "0x80", 2048); float mxa_ = fmaxf(fmaxf(SC[0], SC[1]), fmaxf(SC[2], SC[3])); mxa_ = fmaxf(mxa_, fmaxf(fmaxf(SC[4], SC[5]), fmaxf(SC[6], SC[7]))); SBAR_(); \
        OP[0] = MFMA32(vb_, PP1, OP[0]); vb_ = AP_RD(VB_, "0xa0", 2048); float mxb_ = fmaxf(fmaxf(SC[8], SC[9]), fmaxf(SC[10], SC[11])); mxb_ = fmaxf(mxb_, fmaxf(fmaxf(SC[12], SC[13]), fmaxf(SC[14], SC[15]))); SBAR_(); \
        OP[1] = MFMA32(va_, PP0, OP[1]); va_ = AP_RD0(VB_, 4096); const float mx_ = half_max(fmaxf(mxa_, mxb_)); SBAR_(); \
        OP[1] = MFMA32(vb_, PP1, OP[1]); vb_ = AP_RD(VB_, "0x20", 4096); SBAR_(); \
        if (__any(mx_ > ST.m + ATT_THR)) { const float mn_ = fmaxf(ST.m, mx_), f_ = __builtin_amdgcn_exp2f(ST.m - mn_); ST.m = mn_; ST.l *= f_; \
            _Pragma("unroll") for (int b_ = 0; b_ < 4; ++b_) _Pragma("unroll") for (int r_ = 0; r_ < 16; ++r_) OM[b_][r_] *= f_; } \
        SBAR_(); \
        OP[2] = MFMA32(va_, PP0, OP[2]); va_ = AP_RD(VB_, "0x80", 6144); AP_EXP4(SC, 0, ST.m); SBAR_(); \
        OP[2] = MFMA32(vb_, PP1, OP[2]); vb_ = AP_RD(VB_, "0xa0", 6144); AP_EXP4(SC, 4, ST.m); SBAR_(); \
        OP[3] = MFMA32(va_, PP0, OP[3]); AP_EXP4(SC, 8, ST.m); SBAR_(); \
        OP[3] = MFMA32(vb_, PP1, OP[3]); AP_EXP4(SC, 12, ST.m); SBAR_(); \
        { float sm_ = ((SC[0] + SC[1]) + (SC[2] + SC[3])) + ((SC[4] + SC[5]) + (SC[6] + SC[7])); sm_ += ((SC[8] + SC[9]) + (SC[10] + SC[11])) + ((SC[12] + SC[13]) + (SC[14] + SC[15])); ST.l += sm_; } \
        PC0 = pack8(SC, 0); PC1 = pack8(SC, 1); SBAR_(); } while (0)
#pragma nounroll
    for (int sg = 0; sg < 64; ++sg) {
        const int bc = sg & 3, bp = (sg + 3) & 3, bn = (sg + 1) & 3;
        const int kcur = kaddr + bc * AP_BUFSZ, knext = kaddr + (sg < 63 ? bn : bc) * AP_BUFSZ;
        const int vcur = vaddr + bc * AP_BUFSZ, vprev = vaddr + (sg > 0 ? bp : bc) * AP_BUFSZ;
        const float db = (float)(sg * 32 + 8 * h - qpos);
        AP_ITER(SA, SB, PB0, PB1, PA0, PA1, s1, o1, o2, 1, kcur, "0x80", "0xa0", "0xc0", "0xe0", vprev, db);
        asm volatile("s_waitcnt vmcnt(0)" ::: "memory"); __syncthreads();
        if (sg + 2 < 64) AP_DMA(sg + 2, ((sg + 2) & 3) * AP_BUFSZ);
        AP_ITER(SB, SA, PA0, PA1, PB0, PB1, s2, o2, o1, 0, knext, "0x00", "0x20", "0x40", "0x60", vcur, db);
    }
    {
        const int vlast = vaddr + 3 * AP_BUFSZ;
        o2[0] = MFMA32(AP_RD0(vlast, 0), PB0, o2[0]); o2[0] = MFMA32(AP_RD(vlast, "0x20", 0), PB1, o2[0]);
        o2[1] = MFMA32(AP_RD(vlast, "0x80", 2048), PB0, o2[1]); o2[1] = MFMA32(AP_RD(vlast, "0xa0", 2048), PB1, o2[1]);
        o2[2] = MFMA32(AP_RD0(vlast, 4096), PB0, o2[2]); o2[2] = MFMA32(AP_RD(vlast, "0x20", 4096), PB1, o2[2]);
        o2[3] = MFMA32(AP_RD(vlast, "0x80", 6144), PB0, o2[3]); o2[3] = MFMA32(AP_RD(vlast, "0xa0", 6144), PB1, o2[3]);
    }
    __syncthreads();
#undef AP_ITER
#undef AP_BIAS4
#undef AP_EXP4
#undef AP_RD
#undef AP_RD0
#undef AP_P
#undef AP_RQ
#undef AP_DMA
    unsigned ones2 = ~0u; asm volatile("" : "+s"(ones2)); const int lane2 = (int)__builtin_amdgcn_mbcnt_hi(ones2, __builtin_amdgcn_mbcnt_lo(ones2, 0u));
    const int r_ = lane2 & 31, h_ = lane2 >> 5;
    int l2_ = l; asm volatile("" : "+s"(l2_));
    const float lam_init = 0.8f - 0.6f * __expf(-0.3f * (float)l2_);
    float d1 = 0.f, d2 = 0.f;
#pragma unroll 8
    for (int i = 0; i < 64; ++i) { d1 += A.in[3][l * 64 + i] * A.in[4][l * 64 + i]; d2 += A.in[5][l * 64 + i] * A.in[6][l * 64 + i]; }
    const float lam = __expf(d1) - __expf(d2) + lam_init;
    const float r1 = 1.f / half_sum(s1.l), r2 = lam / half_sum(s2.l);
    float ssq = 0.f;
#pragma unroll
    for (int bb = 0; bb < 4; ++bb)
#pragma unroll
        for (int reg = 0; reg < 16; ++reg) { const float v = o1[bb][reg] * r1 - o2[bb][reg] * r2; o1[bb][reg] = v; ssq += v * v; }
    ssq = half_sum(ssq);
    const float rr = rsqrtf(ssq * (1.f / 128.f) + LN_EPS) * (1.f - lam_init);
    const float* gain = A.in[7] + l * 128;
#pragma unroll
    for (int bb = 0; bb < 4; ++bb)
#pragma unroll
        for (int g4 = 0; g4 < 4; ++g4) { const f32x4 gv = *(const f32x4*)(gain + 32 * bb + 8 * g4 + 4 * h_);
            o1[bb][4 * g4] *= rr * gv.x; o1[bb][4 * g4 + 1] *= rr * gv.y; o1[bb][4 * g4 + 2] *= rr * gv.z; o1[bb][4 * g4 + 3] *= rr * gv.w; }
    store_o<4>(o1, (bf16_t*)(A.ws + WS_BR) + (size_t)NTOK * 512 + (tb + qb * 256 + wave * 32 + r_) * 512 + hd * 128, h_);
}

DI void router_block(const MArgs& A, int l, int vb, LAS unsigned char* lds, int tid, int wave, int lane) {
    const float* Y = (const float*)(A.ws + WS_Y); float* X1F = (float*)(A.ws + WS_X1F); bf16_t* X1B = (bf16_t*)(A.ws + WS_X1B);
    {
        const float* g = A.in[11] + l * DM; const float* bt = A.in[12] + l * DM;
#pragma unroll 1
        for (int k0 = 0; k0 < 8; k0 += 4) {
            f32x4 v[4][4];
#pragma unroll
            for (int k = 0; k < 4; ++k)
#pragma unroll
                for (int j = 0; j < 4; ++j) v[k][j] = *(const f32x4*)(Y + (size_t)(vb * 64 + wave + 8 * (k0 + k)) * DM + 256 * j + 4 * lane);
#pragma unroll
            for (int k = 0; k < 4; ++k) {
                const size_t row = (size_t)(vb * 64 + wave + 8 * (k0 + k)); float sm = 0.f;
#pragma unroll
                for (int j = 0; j < 4; ++j) sm += (v[k][j].x + v[k][j].y) + (v[k][j].z + v[k][j].w);
                const float mean = wave_sum(sm) * (1.f / DM); float s2 = 0.f;
#pragma unroll
                for (int j = 0; j < 4; ++j) { v[k][j] = v[k][j] - mean; s2 += (v[k][j].x * v[k][j].x + v[k][j].y * v[k][j].y) + (v[k][j].z * v[k][j].z + v[k][j].w * v[k][j].w); }
                const float rstd = rsqrtf(wave_sum(s2) * (1.f / DM) + LN_EPS);
#pragma unroll
                for (int j = 0; j < 4; ++j) { const f32x4 gg = *(const f32x4*)(g + 256 * j + 4 * lane), bb = *(const f32x4*)(bt + 256 * j + 4 * lane); const f32x4 o = v[k][j] * rstd * gg + bb;
                    *(f32x4*)(X1F + row * DM + 256 * j + 4 * lane) = o; uint2 pk; pk.x = pk2bf(o.x, o.y); pk.y = pk2bf(o.z, o.w); *(uint2*)(X1B + row * DM + 256 * j + 4 * lane) = pk; }
            }
        }
    }
    __syncthreads();
    LAS float* part = (LAS float*)lds;
    LAS int* lh = (LAS int*)(lds + 16384);
    if (tid < 32) lh[tid] = 0;
    {
        const int tg = wave & 3, kh = wave >> 2, i = lane & 15, kq = lane >> 4;
        const float* xr = X1F + (size_t)(vb * 64 + tg * 16 + i) * DM + kh * 512 + 4 * kq;
        const float* wr = A.in[13] + (size_t)l * DM * 32 + (size_t)(kh * 512 + 4 * kq) * 32 + i;
        f32x4 acc0 = {0.f, 0.f, 0.f, 0.f}, acc1 = {0.f, 0.f, 0.f, 0.f};
#pragma unroll 4
        for (int gk = 0; gk < 32; ++gk) {
            const f32x4 a4 = *(const f32x4*)(xr + 16 * gk);
#pragma unroll
            for (int u = 0; u < 4; ++u) { const float b0 = wr[(16 * gk + u) * 32], b1 = wr[(16 * gk + u) * 32 + 16];
                acc0 = __builtin_amdgcn_mfma_f32_16x16x4f32(a4[u], b0, acc0, 0, 0, 0); acc1 = __builtin_amdgcn_mfma_f32_16x16x4f32(a4[u], b1, acc1, 0, 0, 0); }
        }
#pragma unroll
        for (int reg = 0; reg < 4; ++reg) { const int tk = tg * 16 + 4 * kq + reg; part[(kh * 64 + tk) * 32 + i] = acc0[reg]; part[(kh * 64 + tk) * 32 + 16 + i] = acc1[reg]; }
    }
    __syncthreads();
    if (tid < 64) {
        float lg[32]; const float* br = A.in[14] + l * 32;
#pragma unroll
        for (int e = 0; e < 32; ++e) lg[e] = part[tid * 32 + e] + part[(64 + tid) * 32 + e] + br[e];
        int idx[4]; float val[4];
#pragma unroll
        for (int k = 0; k < 4; ++k) { float best = -INFINITY; int bi = 0;
#pragma unroll
            for (int e = 0; e < 32; ++e) { const bool taken = (k > 0 && idx[0] == e) || (k > 1 && idx[1] == e) || (k > 2 && idx[2] == e); if (!taken && lg[e] > best) { best = lg[e]; bi = e; } }
            idx[k] = bi; val[k] = best; }
        float ls = 0.f, ex[4];
#pragma unroll
        for (int k = 0; k < 4; ++k) { ex[k] = __expf(val[k] - val[0]); ls += ex[k]; }
        int* ti = (int*)(A.ws + WS_TOPI) + (vb * 64 + tid) * 4; float* tw = (float*)(A.ws + WS_TOPW) + (vb * 64 + tid) * 4;
#pragma unroll
        for (int k = 0; k < 4; ++k) { ti[k] = idx[k]; tw[k] = ex[k] / ls; __hip_atomic_fetch_add(&lh[idx[k]], 1, __ATOMIC_RELAXED, __HIP_MEMORY_SCOPE_WORKGROUP); }
    }
    __syncthreads();
    if (tid < 32) ((int*)(A.ws + WS_HIST))[vb * 32 + tid] = lh[tid];
    __syncthreads();
}
DI void dispatch_fast(unsigned char* ws, int vb, LAS int* L, int tid, int nthr, bool f8) {
    const int* hist = (const int*)(ws + WS_HIST); const int* topi = (const int*)(ws + WS_TOPI); const float* topw = (const float*)(ws + WS_TOPW);
    int* tslot = (int*)(ws + WS_TSLOT); int* rtok = (int*)(ws + WS_RTOK); float* rw = (float*)(ws + WS_RW); int* pane = (int*)(ws + WS_PANE);
    LAS int* pc = L; LAS int* pb = L + 512; LAS int* cnt = L + 1024; LAS int* base = L + 1056; LAS int* pstart = L + 1088; LAS int* npan = L + 1120;
    LAS int* sidx = L + 1152; LAS float* sw = (LAS float*)(L + 1408); LAS int* sslot = L + 1664;
    { const int e = tid & 31, ch = tid >> 5, nch = nthr >> 5; int c = 0, bs = 0;
        for (int b2 = ch; b2 < NRB; b2 += nch) { const int hv = hist[b2 * 32 + e]; c += hv; if (b2 < vb) bs += hv; }
        pc[ch * 32 + e] = c; pb[ch * 32 + e] = bs; }
    if (tid < 256) { sidx[tid] = topi[vb * 256 + tid]; sw[tid] = topw[vb * 256 + tid]; }
    __syncthreads();
    if (tid < 32) { const int nch = nthr >> 5; int c = 0, bs = 0; for (int ch = 0; ch < nch; ++ch) { c += pc[ch * 32 + tid]; bs += pb[ch * 32 + tid]; } cnt[tid] = c; base[tid] = bs; }
    __syncthreads();
    if (tid == 0) { int acc = 0; for (int e = 0; e < 32; ++e) { pstart[e] = acc; acc += ((cnt[e] + 255) >> 8) << 8; } npan[0] = acc >> 8; }
    __syncthreads();
    if (tid < 32) {
        const int e = tid; int slot = pstart[e] + base[e];
        for (int a = 0; a < 256; ++a) { if (sidx[a] == e) { sslot[a] = slot; rtok[slot] = vb * 64 + (a >> 2); rw[slot] = sw[a]; ++slot; } }
        if (vb == 0) { const int p0 = pstart[e] >> 8, p1 = p0 + ((cnt[e] + 255) >> 8); for (int p = p0; p < p1; ++p) pane[p] = e; if (e == 0) pane[511] = npan[0]; }
    }
    __syncthreads();
    if (tid < 256) tslot[vb * 256 + tid] = sslot[tid];
    if (f8) {
        const float* x1f = (const float*)(ws + WS_X1F); unsigned char* xs8 = ws + WS_XS; const int wv = tid >> 6, ln = tid & 63, nw = nthr >> 6;
        for (int t = wv; t < 64; t += nw) {
            const float* sp = x1f + (size_t)(vb * 64 + t) * DM + 16 * ln;
            const f32x4 a = *(const f32x4*)sp, b = *(const f32x4*)(sp + 4), c = *(const f32x4*)(sp + 8), d = *(const f32x4*)(sp + 12);
            u32x4_t w; w.x = cvt4_fp8(a.x, a.y, a.z, a.w); w.y = cvt4_fp8(b.x, b.y, b.z, b.w); w.z = cvt4_fp8(c.x, c.y, c.z, c.w); w.w = cvt4_fp8(d.x, d.y, d.z, d.w);
#pragma unroll
            for (int k = 0; k < 4; ++k) *(u32x4_t*)(xs8 + (size_t)sslot[4 * t + k] * 1024 + 16 * ln) = w;
        }
        __syncthreads(); return;
    }
    const bf16_t* x1b = (const bf16_t*)(ws + WS_X1B); bf16_t* xs = (bf16_t*)(ws + WS_XS);
    { const int wv = tid >> 6, ln = tid & 63, nw = nthr >> 6;
        for (int t = wv; t < 64; t += 2 * nw) {
            const int t2 = t + nw; const bool has2 = t2 < 64;
            const bf16_t* s0 = x1b + (size_t)(vb * 64 + t) * DM + 8 * ln; const bf16_t* s1 = x1b + (size_t)(vb * 64 + (has2 ? t2 : t)) * DM + 8 * ln;
            const u32x4_t a0 = *(const u32x4_t*)s0, a1 = *(const u32x4_t*)(s0 + 512), b0 = *(const u32x4_t*)s1, b1 = *(const u32x4_t*)(s1 + 512);
#pragma unroll
            for (int k = 0; k < 4; ++k) { bf16_t* d = xs + (size_t)sslot[4 * t + k] * DM + 8 * ln; *(u32x4_t*)d = a0; *(u32x4_t*)(d + 512) = a1; }
            if (has2) {
#pragma unroll
                for (int k = 0; k < 4; ++k) { bf16_t* d = xs + (size_t)sslot[4 * t2 + k] * DM + 8 * ln; *(u32x4_t*)d = b0; *(u32x4_t*)(d + 512) = b1; } }
        } }
    __syncthreads();
}

typedef const __attribute__((address_space(4))) MArgs* kargs_ptr;
DI MArgs load_margs(kargs_ptr p) { MArgs a;
#pragma unroll
    for (int i = 0; i < 21; ++i) a.in[i] = p->in[i];
    a.out = p->out; a.ws = p->ws; a.ph_lo = p->ph_lo; a.ph_hi = p->ph_hi; return a; }
#define PHASE_ARGS() kargs_ptr ap_ = (kargs_ptr)__builtin_amdgcn_kernarg_segment_ptr(); asm volatile("" : "+s"(ap_)); const MArgs A = load_margs(ap_); \
    int gw = gw0, vcu = vcu0, bx = bx0, wave = wave0; asm volatile("" : "+s"(gw), "+s"(vcu), "+s"(bx), "+s"(wave)); \
    unsigned ones_ = ~0u; asm volatile("" : "+s"(ones_)); int lane = (int)__builtin_amdgcn_mbcnt_hi(ones_, __builtin_amdgcn_mbcnt_lo(ones_, 0u)); int tid = wave * 64 + lane
__global__ void __launch_bounds__(NTHREADS, 2) mega(MArgs A_unused) {
    extern __shared__ __attribute__((aligned(256))) unsigned char lds_raw[];
    LAS unsigned char* lds = (LAS unsigned char*)lds_raw;
    const int tid0 = threadIdx.x, lane0 = tid0 & 63, wave0 = __builtin_amdgcn_readfirstlane(tid0 >> 6);
    const int G = gridDim.x, bx0 = blockIdx.x, vcu0 = (G % 8 == 0) ? (bx0 % 8) * (G / 8) + bx0 / 8 : bx0;
    const int gw0 = vcu0 * NWAVES + wave0, ngw = G * NWAVES;
    volatile LAS unsigned* misc = (volatile LAS unsigned*)(lds + LDS_MISC);
    if (tid0 < 64) misc[tid0] = 0u;
    __syncthreads();
    int lo, hi; XcdBarrier bar;
    { PHASE_ARGS(); (void)gw; (void)vcu; (void)bx; (void)tid; (void)lane; (void)wave; lo = A.ph_lo; hi = A.ph_hi; bar = xcd_barrier_post((unsigned*)(A.ws + WS_CTL) + CW_BAR, misc + 8); }
#define IN(k) (lo <= (k) && (k) < hi)
#define SEAM(k) do { if (IN(k) && IN((k) + 1)) xcd_barrier(bar); } while (0)
    if (IN(0)) { PHASE_ARGS(); prologue_phase(A, lds, gw, ngw, wave, lane); }
    SEAM(0);
    if ((PROBE_REP & 512) && IN(0)) { PHASE_ARGS(); prologue_phase(A, lds, gw, ngw, wave, lane); xcd_barrier(bar); }
    for (int l = 0; l < 2; ++l) {
        const int pb = 1 + 9 * l;
        for (int rep = 0; rep < (((PROBE_REP >> 0) & 1) ? 2 : 1); ++rep)
        if (IN(pb + 0)) {
            PHASE_ARGS(); const pg8::Gemm gm{(const bf16_t*)A.ws, (const bf16_t*)A.ws, 0, 0, DM};
            const int xb0 = (int)(WS_XB >> 19), w0 = (int)((WS_W + (size_t)l * WL_BYTES + WL_IN) >> 19);
            SchedInProj S; S.so.init(NTOK, 28 * 256, G, bx); S.xb0 = xb0; S.w0 = w0;
            EpiInProj E{A.ws, xb0, w0};
            pg8::gemm_phase<EpiInProj, SchedInProj, true, true>(lds, gm, S, E, wave);
        }
        SEAM(pb + 0);
        for (int rep = 0; rep < (((PROBE_REP >> 1) & 1) ? 2 : 1); ++rep)
        if (IN(pb + 1)) {
            PHASE_ARGS();
            { int nrep_ = (PROBE_REP & 1024) ? 2 : 1; asm volatile("" : "+s"(nrep_));
#pragma nounroll
              for (int rp_ = 0; rp_ < nrep_; ++rp_) if (vcu < 256) attn_b_unit2(A, l, vcu, lds, wave, lane); }
            for (int t = gw; t < 4096; t += ngw) attn_a_task(A, l, t, lane);
            if (PROBE_REP & 2048) for (int t = gw; t < 4096; t += ngw) attn_a_task(A, l, t, lane);
            for (int t = gw; t < 4096; t += ngw) attn_c_task(A, l, t, lane, (LAS float*)(lds + wave * 4096));
            if (PROBE_REP & 4096) for (int t = gw; t < 4096; t += ngw) attn_c_task(A, l, t, lane, (LAS float*)(lds + wave * 4096));
        }
        SEAM(pb + 1);
        for (int rep = 0; rep < (((PROBE_REP >> 2) & 1) ? 2 : 1); ++rep)
        if (IN(pb + 2)) {
            PHASE_ARGS(); const pg8::Gemm gm512{(const bf16_t*)A.ws, (const bf16_t*)A.ws, 0, 0, 512};
            const int a0 = (int)(WS_BR >> 18), b0 = (int)((WS_W + (size_t)l * WL_BYTES + WL_BR) >> 18);
            SchedBranch S{vcu, G, a0, b0};
            EpiBranch E{A.ws, a0, b0};
            pg8::gemm_phase<EpiBranch, SchedBranch, true, true>(lds, gm512, S, E, wave);
        }
        SEAM(pb + 2);
        for (int rep = 0; rep < (((PROBE_REP >> 3) & 1) ? 2 : 1); ++rep)
        if (IN(pb + 3)) {
            PHASE_ARGS(); const pg8::Gemm gm{(const bf16_t*)A.ws, (const bf16_t*)A.ws, 0, 0, DM};
            const float* xcur = l == 0 ? A.in[0] : (const float*)(A.ws + WS_XF);
            const int a0 = (int)(WS_MB >> 19), b0 = (int)((WS_W + (size_t)l * WL_BYTES + WL_OUT) >> 19);
            SchedPlain S; S.so.init(NTOK, DM, G, bx); S.a0 = a0; S.b0 = b0;
            EpiWout E{xcur, (float*)(A.ws + WS_Y), a0, b0};
            pg8::gemm_phase<EpiWout, SchedPlain, false, true>(lds, gm, S, E, wave);
        }
        SEAM(pb + 3);
        for (int rep = 0; rep < (((PROBE_REP >> 4) & 1) ? 2 : 1); ++rep)
        if (IN(pb + 4)) { PHASE_ARGS(); for (int vb = vcu; vb < NRB; vb += G) router_block(A, l, vb, lds, tid, wave, lane); }
        SEAM(pb + 4);
        for (int rep = 0; rep < (((PROBE_REP >> 5) & 1) ? 2 : 1); ++rep)
        if (IN(pb + 5)) { PHASE_ARGS(); for (int vb = vcu; vb < NRB; vb += G) dispatch_fast(A.ws, vb, (LAS int*)lds, tid, NTHREADS, ((F8_LAYERS >> l) & 1) != 0); }
        SEAM(pb + 5);
        for (int rep = 0; rep < (((PROBE_REP >> 6) & 1) ? 2 : 1); ++rep)
        if (IN(pb + 6)) {
            PHASE_ARGS();
            const int* pane = (const int*)(A.ws + WS_PANE); const int np = __builtin_amdgcn_readfirstlane(pane[511]);
            if ((F8_LAYERS >> l) & 1) {
                int k8_ = 512; asm volatile("" : "+s"(k8_)); const pg8::Gemm gm8{(const bf16_t*)A.ws, (const bf16_t*)A.ws, 127 - F8_WUP_SH, 0, k8_};
                const int a0 = (int)(WS_XS >> 18), b0 = (int)((WS_W + (size_t)l * WL_BYTES + WL_UP) >> 18);
                SchedMoe S{pane, 8, a0, b0, G, bx, np * 8};
                EpiUp<true> E{A.ws, A.in[16] + (size_t)l * NE * 2048, a0, b0};
                pg8::gemm_phase<EpiUp<true>, SchedMoe, true, true, true>(lds, gm8, S, E, wave);
            } else {
                const pg8::Gemm gm{(const bf16_t*)A.ws, (const bf16_t*)A.ws, 0, 0, DM};
                const int a0 = (int)(WS_XS >> 19), b0 = (int)((WS_W + (size_t)l * WL_BYTES + WL_UP) >> 19);
                SchedMoe S{pane, 8, a0, b0, G, bx, np * 8};
                EpiUp<false> E{A.ws, A.in[16] + (size_t)l * NE * 2048, a0, b0};
                pg8::gemm_phase<EpiUp<false>, SchedMoe, true, true>(lds, gm, S, E, wave);
            }
        }
        SEAM(pb + 6);
        for (int rep = 0; rep < (((PROBE_REP >> 7) & 1) ? 2 : 1); ++rep)
        if (IN(pb + 7)) {
            PHASE_ARGS();
            const int* pane = (const int*)(A.ws + WS_PANE); const int np = __builtin_amdgcn_readfirstlane(pane[511]);
            if ((F8_LAYERS >> l) & 1) {
                int k8_ = 512; asm volatile("" : "+s"(k8_)); const pg8::Gemm gm8{(const bf16_t*)A.ws, (const bf16_t*)A.ws, 127 - F8_WDN_SH, 0, k8_};
                const int a0 = (int)(WS_ACTB >> 18), b0 = (int)((WS_W + (size_t)l * WL_BYTES + WL_DN) >> 18);
                SchedMoe S{pane, 4, a0, b0, G, bx, np * 4};
                EpiDown E{A.ws, A.in[18] + (size_t)l * NE * DM, a0, b0};
                pg8::gemm_phase<EpiDown, SchedMoe, true, true, true>(lds, gm8, S, E, wave);
            } else {
                const pg8::Gemm gm{(const bf16_t*)A.ws, (const bf16_t*)A.ws, 0, 0, DM};
                const int a0 = (int)(WS_ACTB >> 19), b0 = (int)((WS_W + (size_t)l * WL_BYTES + WL_DN) >> 19);
                SchedMoe S{pane, 4, a0, b0, G, bx, np * 4};
                EpiDown E{A.ws, A.in[18] + (size_t)l * NE * DM, a0, b0};
                pg8::gemm_phase<EpiDown, SchedMoe, true, true>(lds, gm, S, E, wave);
            }
        }
        SEAM(pb + 7);
        for (int rep = 0; rep < (((PROBE_REP >> 8) & 1) ? 2 : 1); ++rep)
        if (IN(pb + 8)) {
            PHASE_ARGS();
            float* outF = l == 0 ? (float*)(A.ws + WS_XF) : A.out; bf16_t* outB = l == 0 ? (bf16_t*)(A.ws + WS_XB) : nullptr;
            for (int tok = gw; tok < NTOK; tok += ngw) combine_row(A.ws, tok, A.in[19] + l * DM, A.in[20] + l * DM, outF, outB, lane);
        }
        SEAM(pb + 8);
    }
#undef IN
#undef SEAM
}

#ifndef FASTMASK
#define FASTMASK 0x1FF
#endif
#ifndef ONE_LAUNCH
#define ONE_LAUNCH 1
#endif
static void launch_mega(const MArgs& a0, int lo, int hi, hipStream_t stream) {
    MArgs a = a0; a.ph_lo = lo; a.ph_hi = hi;
    hipLaunchKernelGGL(mega, dim3(256), dim3(NTHREADS), LDS_BYTES, stream, a);
}
extern "C" void kernel_launch(void* const* d_in, const int* in_sizes, int n_in, void* d_out, int out_size, void* d_ws, size_t ws_size, hipStream_t stream) {
    if (n_in != 21 || ws_size < WS_END) { fprintf(stderr, "kernel_launch: unexpected inputs (n_in %d, ws %zu)\n", n_in, ws_size); return; }
    static int ready = 0;
    if (!ready) { if (hipFuncSetAttribute((const void*)mega, hipFuncAttributeMaxDynamicSharedMemorySize, LDS_BYTES) != hipSuccess) { fprintf(stderr, "hipFuncSetAttribute failed\n"); } ready = 1; }
    unsigned char* ws = (unsigned char*)d_ws;
    const float* x_in = (const float*)d_in[0];
    (void)hipMemsetAsync(ws + WS_CTL, 0, 1 * MiB, stream);
    MArgs ma{};
    for (int i = 0; i < 21; ++i) ma.in[i] = (const float*)d_in[i];
    ma.out = (float*)d_out; ma.ws = ws;
    if (ONE_LAUNCH) { launch_mega(ma, 0, NPHASE, stream); return; }
    const unsigned fm = FASTMASK;
    if (fm) launch_mega(ma, 0, 1, stream);
    for (int l = 0; l < 2; ++l) {
        const int pb = 1 + 9 * l;
        const float* xcur = l == 0 ? x_in : (const float*)(ws + WS_XF);
        float* xnext = l == 0 ? (float*)(ws + WS_XF) : (float*)d_out;
        const float* w_in = (const float*)d_in[1] + (size_t)l * DM * IN_W;
        const float* a_sink = (const float*)d_in[2] + l * 8;
        const float* lq1 = (const float*)d_in[3] + l * 64; const float* lk1 = (const float*)d_in[4] + l * 64;
        const float* lq2 = (const float*)d_in[5] + l * 64; const float* lk2 = (const float*)d_in[6] + l * 64;
        const float* dng = (const float*)d_in[7] + l * 128;
        const float* rpb = (const float*)d_in[8] + (size_t)l * 8 * 15 * 31;
        const float* w_br = (const float*)d_in[9] + (size_t)l * 3 * 512 * DM;
        const float* w_out = (const float*)d_in[10] + (size_t)l * DM * DM;
        const float* ln1g = (const float*)d_in[11] + l * DM; const float* ln1b = (const float*)d_in[12] + l * DM;
        const float* w_r = (const float*)d_in[13] + (size_t)l * DM * 32; const float* b_r = (const float*)d_in[14] + l * 32;
        const float* w_up = (const float*)d_in[15] + (size_t)l * NE * DM * 2048; const float* b_up = (const float*)d_in[16] + (size_t)l * NE * 2048;
        const float* w_dn = (const float*)d_in[17] + (size_t)l * NE * FE * DM; const float* b_dn = (const float*)d_in[18] + (size_t)l * NE * DM;
        const float* ln2g = (const float*)d_in[19] + l * DM; const float* ln2b = (const float*)d_in[20] + l * DM;
        const float lam_init = 0.8f - 0.6f * expf(-0.3f * (float)l);
        if (fm & 1) launch_mega(ma, pb + 0, pb + 1, stream);
        else nv_gemm<AF32, BKN, EInProj, 1><<<dim3(IN_W / 64, NTOK / 64), 256, 0, stream>>>(AF32{xcur, DM}, BKN{w_in, IN_W, 0}, EInProj{ws}, nullptr, NTOK, IN_W, DM, 0);
        if (fm & 2) launch_mega(ma, pb + 1, pb + 2, stream);
        else {
            nv_attn_a<<<NTOK * 8 / 4, 256, 0, stream>>>((const bf16_t*)(ws + WS_QA), (const bf16_t*)(ws + WS_KA), (const bf16_t*)(ws + WS_VT), (bf16_t*)(ws + WS_BR), a_sink);
            nv_attn_b<<<NTOK * 4 / 4, 256, 0, stream>>>((const bf16_t*)(ws + WS_QB), (const bf16_t*)(ws + WS_KB), (const bf16_t*)(ws + WS_VT), (bf16_t*)(ws + WS_BR) + (size_t)NTOK * 512, lq1, lk1, lq2, lk2, dng, lam_init);
            nv_attn_c<<<NTOK * 8 / 4, 256, 0, stream>>>((const bf16_t*)(ws + WS_QC), (const bf16_t*)(ws + WS_KC), (const bf16_t*)(ws + WS_VT), (bf16_t*)(ws + WS_BR) + (size_t)2 * NTOK * 512, rpb);
        }
        if (fm & 4) launch_mega(ma, pb + 2, pb + 3, stream);
        else for (int i = 0; i < 3; ++i)
            nv_gemm<ABF, BKN, EBranch, 1><<<dim3(DM / 64, NTOK / 64), 256, 0, stream>>>(ABF{(const bf16_t*)(ws + WS_BR) + (size_t)i * NTOK * 512, 512}, BKN{w_br + (size_t)i * 512 * DM, DM, 0}, EBranch{ws, i}, nullptr, NTOK, DM, 512, 0);
        if (fm & 8) launch_mega(ma, pb + 3, pb + 4, stream);
        else nv_gemm<AF32, BKN, EWout, 1><<<dim3(DM / 64, NTOK / 64), 256, 0, stream>>>(AF32{(const float*)(ws + WS_MF), DM}, BKN{w_out, DM, 0}, EWout{xcur, (float*)(ws + WS_Y)}, nullptr, NTOK, DM, DM, 0);
        if (fm & 16) launch_mega(ma, pb + 4, pb + 5, stream);
        else {
            k_ln1<<<NTOK / 4, 256, 0, stream>>>((const float*)(ws + WS_Y), ln1g, ln1b, (float*)(ws + WS_X1F), (bf16_t*)(ws + WS_X1B));
            k_router_naive<<<NTOK * 32 / 256, 256, 0, stream>>>((const float*)(ws + WS_X1F), w_r, b_r, (float*)(ws + WS_LOGIT));
            k_topk<<<NTOK / 256, 256, 0, stream>>>((const float*)(ws + WS_LOGIT), (int*)(ws + WS_TOPI), (float*)(ws + WS_TOPW));
            k_hist<<<NRB, 256, 0, stream>>>(ws);
        }
        (void)hipMemsetAsync(ws + WS_RTOK, 0xFF, NPADROWS * 4, stream);
        if (fm & 32) launch_mega(ma, pb + 5, pb + 6, stream);
        else k_dispatch<<<NRB, 256, 0, stream>>>(ws);
        if (fm & 64) launch_mega(ma, pb + 6, pb + 7, stream);
        else nv_gemm<AGather, BExp, EUp, 2><<<dim3(FE / 64, NPADROWS / 64), 256, 0, stream>>>(AGather{(const float*)(ws + WS_X1F), (const int*)(ws + WS_RTOK)},
            BExp{w_up, (const int*)(ws + WS_PANE), (size_t)DM * 2048, 2048, 1024}, EUp{b_up, (const int*)(ws + WS_PANE), (bf16_t*)(ws + WS_ACTB)}, (const int*)(ws + WS_PANE) + 511, NPADROWS, FE, DM, 0);
        if (fm & 128) launch_mega(ma, pb + 7, pb + 8, stream);
        else nv_gemm<ABF, BExp, EDown, 1><<<dim3(DM / 64, NPADROWS / 64), 256, 0, stream>>>(ABF{(const bf16_t*)(ws + WS_ACTB), FE},
            BExp{w_dn, (const int*)(ws + WS_PANE), (size_t)FE * DM, DM, 0}, EDown{b_dn, (const int*)(ws + WS_PANE), (const float*)(ws + WS_RW), (bf16_t*)(ws + WS_YS)}, (const int*)(ws + WS_PANE) + 511, NPADROWS, DM, FE, 0);
        if (fm & 256) launch_mega(ma, pb + 8, pb + 9, stream);
        else k_combine<<<NTOK / 4, 256, 0, stream>>>(ws, ln2g, ln2b, xnext, l == 0 ? (bf16_t*)(ws + WS_XB) : nullptr);
    }
}
```
